# Optimizing an MI355X kernel written in HIP

```python
import math
import jax, jax.numpy as jnp
from jax import lax
import numpy as np

D_MODEL = 1024
BATCH = 16
SEQ = 4096
DEPTH = 4

CHUNK = 64
D_MIX = D_MODEL
D_HGRN = D_MIX // 2
HGRN_HEADS = 4
HGRN_HEAD_DIM = D_HGRN // HGRN_HEADS
D_SB = D_MIX - D_HGRN
SB_HEADS = 8
SB_HEAD_DIM = D_SB // SB_HEADS
Q_BLOCK = 128
IN_SPLITS = (D_HGRN, 2 * D_HGRN, 3 * D_HGRN, 4 * D_HGRN, 4 * D_HGRN + D_SB, 4 * D_HGRN + 2 * D_SB)
D_IN_PROJ = 4 * D_HGRN + 3 * D_SB
D_FF_DENSE = 2816
N_EXPERTS = 8
TOP_K = 2
D_FF_EXPERT = 3584
N_DENSE = (DEPTH + 1) // 2
N_MOE = DEPTH // 2
DEEPNORM_ALPHA = (2 * DEPTH) ** 0.25
DEEPNORM_BETA = (8 * DEPTH) ** -0.25
LN_EPS = 1e-5
RMS_EPS = 1e-6

kernel_name = "hybrid_hgrn2_stickbreaking_moe_deepnorm"


def layer_norm(x, gain, bias):
    xf = x.astype(jnp.float32)
    mu = jnp.mean(xf, axis=-1, keepdims=True)
    var = jnp.mean(jnp.square(xf - mu), axis=-1, keepdims=True)
    return ((xf - mu) * lax.rsqrt(var + LN_EPS)).astype(x.dtype) * gain + bias


def ada_modulation(c, w, b):
    m = (jax.nn.silu(c) @ w + b)[:, None, :]
    return jnp.split(m, 3, axis=-1)


def hgrn_lower_bounds(lb_logits):
    p = jax.nn.softmax(lb_logits.astype(jnp.float32), axis=0)
    return (jnp.cumsum(p, axis=0) - p[0:1]).astype(lb_logits.dtype)


def hgrn2_mixer(q, f_logit, i, g, lb, norm_gain):
    B, S, _ = q.shape
    n_chunks = S // CHUNK
    f = lb + (1.0 - lb) * jax.nn.sigmoid(f_logit)
    log_f = jnp.log(f)
    k = 1.0 - f
    q = jax.nn.silu(q)

    def to_chunks(t):
        return t.reshape(B, n_chunks, CHUNK, HGRN_HEADS, HGRN_HEAD_DIM).transpose(1, 0, 3, 2, 4)

    causal = jnp.tril(jnp.ones((CHUNK, CHUNK), dtype=bool))[:, :, None]

    def step(state, inp):
        qc, gc, kc, vc = inp
        b = jnp.cumsum(gc, axis=2)
        o_inter = jnp.einsum('bhck,bhkv->bhcv', qc * jnp.exp(b), state)
        diff = b[:, :, :, None, :] - b[:, :, None, :, :]
        decay = jnp.exp(jnp.where(causal, diff, -jnp.inf))
        scores = jnp.sum(qc[:, :, :, None, :] * decay * kc[:, :, None, :, :], axis=-1)
        o_intra = jnp.einsum('bhts,bhsv->bhtv', scores, vc)
        b_last = b[:, :, -1:, :]
        k_dec = kc * jnp.exp(b_last - b)
        state = jnp.exp(b_last)[:, :, 0, :, None] * state + jnp.einsum('bhsk,bhsv->bhkv', k_dec, vc)
        return state, o_inter + o_intra

    state0 = jnp.zeros((B, HGRN_HEADS, HGRN_HEAD_DIM, HGRN_HEAD_DIM), dtype=q.dtype)
    _, o = lax.scan(step, state0, (to_chunks(q), to_chunks(log_f), to_chunks(k), to_chunks(i)))
    o = o.transpose(1, 0, 3, 2, 4).reshape(B, S, HGRN_HEADS, HGRN_HEAD_DIM)
    of = o.astype(jnp.float32)
    o = (of * lax.rsqrt(jnp.mean(jnp.square(of), axis=-1, keepdims=True) + RMS_EPS)).astype(q.dtype)
    return o.reshape(B, S, D_HGRN) * norm_gain * jax.nn.silu(g)


def stick_breaking_mixer(q, k, v):
    B, S, _ = q.shape

    def heads(t):
        return t.reshape(B, S, SB_HEADS, SB_HEAD_DIM).transpose(0, 2, 1, 3)

    q, k, v = heads(q), heads(k), heads(v)
    scale = SB_HEAD_DIM ** -0.5
    outs = []
    for start in range(0, S, Q_BLOCK):
        end = start + Q_BLOCK
        qb, kb, vb = q[:, :, start:end], k[:, :, :end], v[:, :, :end]
        z = jnp.einsum('bhqd,bhkd->bhqk', qb, kb).astype(jnp.float32) * scale
        t_pos = start + jnp.arange(Q_BLOCK)[:, None]
        s_pos = jnp.arange(end)[None, :]
        strict = s_pos < t_pos
        log_not = jnp.where(strict, jax.nn.log_sigmoid(-z), 0.0)
        after = lax.cumsum(log_not, axis=3, reverse=True) - log_not
        a = jnp.where(strict, jnp.exp(jax.nn.log_sigmoid(z) + after), 0.0)
        outs.append(jnp.einsum('bhqk,bhkd->bhqd', a.astype(vb.dtype), vb))
    o = jnp.concatenate(outs, axis=2)
    return o.transpose(0, 2, 1, 3).reshape(B, S, D_SB)


def token_mixer(h, w_in, w_out, lb, hgrn_norm_gain):
    proj = h @ w_in
    hq, hf, hi, hg, sq, sk, sv = jnp.split(proj, IN_SPLITS, axis=-1)
    o_hgrn = hgrn2_mixer(hq, hf, hi, hg, lb, hgrn_norm_gain)
    o_sb = stick_breaking_mixer(sq, sk, sv)
    return jnp.concatenate([o_hgrn, o_sb], axis=-1) @ w_out


def swiglu(h, wg, wu, wd):
    return (jax.nn.silu(h @ wg) * (h @ wu)) @ wd


def moe_swiglu(h, w_router, wg, wu, wd):
    logits = (h @ w_router).astype(jnp.float32)
    top_v, top_i = lax.top_k(logits, TOP_K)
    top_w = jax.nn.softmax(top_v, axis=-1).astype(h.dtype)
    combine = jnp.sum(jax.nn.one_hot(top_i, N_EXPERTS, dtype=h.dtype) * top_w[..., None], axis=-2)
    y = jnp.zeros_like(h)
    for e in range(N_EXPERTS):
        y = y + combine[..., e:e + 1] * swiglu(h, wg[e], wu[e], wd[e])
    return y


def setup_inputs(seed: int = 0) -> dict:
    key = jax.random.key(seed)
    ks = jax.random.split(key, 18)
    f32 = jnp.float32
    beta = DEEPNORM_BETA
    x = jax.random.normal(ks[0], (BATCH, SEQ, D_MODEL), f32)
    c = jax.random.normal(ks[1], (BATCH, D_MODEL), f32)
    w_ada = jax.random.normal(ks[2], (DEPTH, 2, D_MODEL, 3 * D_MODEL), f32) * (0.5 * D_MODEL ** -0.5)
    b_ada = jax.random.normal(ks[3], (DEPTH, 2, 3 * D_MODEL), f32) * 0.02
    col_scale = jnp.concatenate([
        jnp.ones((2 * D_HGRN,), f32), jnp.full((D_HGRN,), beta, f32),
        jnp.ones((D_HGRN + 2 * D_SB,), f32), jnp.full((D_SB,), beta, f32)])
    w_in = jax.random.normal(ks[4], (DEPTH, D_MODEL, D_IN_PROJ), f32) * (D_MODEL ** -0.5) * col_scale
    w_out = jax.random.normal(ks[5], (DEPTH, D_MIX, D_MODEL), f32) * (D_MIX ** -0.5) * beta
    hgrn_lb_logits = jax.random.normal(ks[6], (DEPTH, D_HGRN), f32)
    hgrn_norm_gain = 1.0 + 0.02 * jax.random.normal(ks[7], (DEPTH, D_HGRN), f32)
    w_dense_gate = jax.random.normal(ks[8], (N_DENSE, D_MODEL, D_FF_DENSE), f32) * (D_MODEL ** -0.5) * beta
    w_dense_up = jax.random.normal(ks[9], (N_DENSE, D_MODEL, D_FF_DENSE), f32) * (D_MODEL ** -0.5) * beta
    w_dense_down = jax.random.normal(ks[10], (N_DENSE, D_FF_DENSE, D_MODEL), f32) * (D_FF_DENSE ** -0.5) * beta
    w_router = jax.random.normal(ks[11], (N_MOE, D_MODEL, N_EXPERTS), f32) * (D_MODEL ** -0.5)
    w_moe_gate = jax.random.normal(ks[12], (N_MOE, N_EXPERTS, D_MODEL, D_FF_EXPERT), f32) * (D_MODEL ** -0.5) * beta
    w_moe_up = jax.random.normal(ks[13], (N_MOE, N_EXPERTS, D_MODEL, D_FF_EXPERT), f32) * (D_MODEL ** -0.5) * beta
    w_moe_down = jax.random.normal(ks[14], (N_MOE, N_EXPERTS, D_FF_EXPERT, D_MODEL), f32) * (D_FF_EXPERT ** -0.5) * beta
    ln_gain = 1.0 + 0.02 * jax.random.normal(ks[15], (DEPTH, 2, D_MODEL), f32)
    ln_bias = 0.02 * jax.random.normal(ks[16], (DEPTH, 2, D_MODEL), f32)
    return {"x": x, "c": c, "w_ada": w_ada, "b_ada": b_ada, "w_in": w_in, "w_out": w_out,
            "hgrn_lb_logits": hgrn_lb_logits, "hgrn_norm_gain": hgrn_norm_gain,
            "w_dense_gate": w_dense_gate, "w_dense_up": w_dense_up, "w_dense_down": w_dense_down,
            "w_router": w_router, "w_moe_gate": w_moe_gate, "w_moe_up": w_moe_up, "w_moe_down": w_moe_down,
            "ln_gain": ln_gain, "ln_bias": ln_bias}


def reference(x, c, w_ada, b_ada, w_in, w_out, hgrn_lb_logits, hgrn_norm_gain,
              w_dense_gate, w_dense_up, w_dense_down, w_router, w_moe_gate, w_moe_up, w_moe_down,
              ln_gain, ln_bias):
    lb_all = hgrn_lower_bounds(hgrn_lb_logits)
    for layer in range(DEPTH):
        shift, scale, gate = ada_modulation(c, w_ada[layer, 0], b_ada[layer, 0])
        h = x * (1.0 + scale) + shift
        y = token_mixer(h, w_in[layer], w_out[layer], lb_all[layer], hgrn_norm_gain[layer])
        x = layer_norm(DEEPNORM_ALPHA * x + gate * y, ln_gain[layer, 0], ln_bias[layer, 0])
        shift, scale, gate = ada_modulation(c, w_ada[layer, 1], b_ada[layer, 1])
        h = x * (1.0 + scale) + shift
        if layer % 2 == 0:
            j = layer // 2
            y = swiglu(h, w_dense_gate[j], w_dense_up[j], w_dense_down[j])
        else:
            j = layer // 2
            y = moe_swiglu(h, w_router[j], w_moe_gate[j], w_moe_up[j], w_moe_down[j])
        x = layer_norm(DEEPNORM_ALPHA * x + gate * y, ln_gain[layer, 1], ln_bias[layer, 1])
    return x
```

```cpp
#include <hip/hip_runtime.h>
#include <cstdio>
#include <cstdint>

#ifndef MK_PER_PHASE_LAUNCH
#define MK_PER_PHASE_LAUNCH 0
#endif

#define GAS __attribute__((address_space(1)))
#define LAS __attribute__((address_space(3)))
typedef unsigned short bf16;
typedef short bf16x8 __attribute__((ext_vector_type(8)));
typedef short s16x4 __attribute__((ext_vector_type(4)));
typedef float f32x4 __attribute__((ext_vector_type(4)));
typedef float f32x16 __attribute__((ext_vector_type(16)));
typedef unsigned u32x4 __attribute__((ext_vector_type(4)));
typedef unsigned u32x2 __attribute__((ext_vector_type(2)));
typedef int i32x4 __attribute__((ext_vector_type(4)));
typedef int i32x8 __attribute__((ext_vector_type(8)));
typedef GAS unsigned gu32;

constexpr int NB = 16, SEQ = 4096, D = 1024, M = NB * SEQ, DEPTH = 4;
constexpr int NPROJ = 3584, DFF = 2816, DFFE = 3584, NE = 8;
constexpr int C_HQ = 0, C_HG = 512, C_HV = 1024, C_HGATE = 1536, C_SQ = 2048, C_SK = 2560, C_SV = 3072;
constexpr float ALPHA = 1.681792830507429f;
constexpr float LN_EPS = 1e-5f, RMS_EPS = 1e-6f;
constexpr float LOG2E = 1.4426950408889634f;
constexpr float HID_SCALE = 16.0f, WDN_SCALE = 256.0f, H2_SCALE = 8.0f, WGU_SCALE = 128.0f;
constexpr int NWAVES = 8, NTHR = 512;

constexpr size_t MiB = 1u << 20;
constexpr size_t WS_CTL = 0, CTL_ZERO_BYTES = 1 * MiB;
constexpr size_t WS_MOD = 1 * MiB;
constexpr size_t WS_LB = WS_MOD + 1536 * 1024;
constexpr size_t WS_HSC = WS_LB + 65536;
constexpr size_t WS_ROUTE = 3 * MiB;
constexpr size_t WS_LIST = 4 * MiB;
constexpr size_t WS_HD = 6 * MiB;
constexpr size_t WS_WIN = 8 * MiB;
constexpr size_t WS_WOUT = 15 * MiB;
constexpr size_t WS_WGU = 17 * MiB;
constexpr size_t WS_WDN = 129 * MiB;
constexpr size_t WS_RS = WS_WGU + 56 * MiB;
constexpr size_t WS_RD = WS_RS + 8 * MiB;
constexpr size_t WS_HB = 185 * MiB;
constexpr size_t WS_PROJ = 313 * MiB;
constexpr size_t WS_YP = 768 * MiB;
constexpr size_t WS_XH = 896 * MiB;
constexpr size_t WS_END = 1024 * MiB;
constexpr int CW_TMO = 0;
constexpr int CW_BAR = 4096;
constexpr int CW_WMAX = 131072;
constexpr int CW_CNT = 16384;

constexpr int LDS_BYTES = 163840;
constexpr int MISC_OFF = LDS_BYTES - 256;

#define RLX_AGENT __ATOMIC_RELAXED, __HIP_MEMORY_SCOPE_AGENT
#define LDS_WAIT() asm volatile("s_waitcnt lgkmcnt(0)" ::: "memory")
#define VM_WAIT() asm volatile("s_waitcnt vmcnt(0)" ::: "memory")

__device__ __forceinline__ float bf2f(unsigned short b) { return __builtin_bit_cast(float, (unsigned)b << 16); }
__device__ __forceinline__ float bflo(unsigned w) { return __builtin_bit_cast(float, w << 16); }
__device__ __forceinline__ float bfhi(unsigned w) { return __builtin_bit_cast(float, w & 0xffff0000u); }
typedef _Float16 f16x4_t __attribute__((ext_vector_type(4)));
typedef float f32x2_t __attribute__((ext_vector_type(2))); typedef __bf16 bf16x2_t __attribute__((ext_vector_type(2)));
__device__ __forceinline__ unsigned cvt_pk_bf16(float lo, float hi) { f32x2_t v = {lo, hi}; bf16x2_t b = __builtin_convertvector(v, bf16x2_t); return __builtin_bit_cast(unsigned, b); }
__device__ __forceinline__ unsigned pk2(float lo, float hi) { return cvt_pk_bf16(lo, hi); }
__device__ __forceinline__ unsigned f2bf(float f) { return cvt_pk_bf16(f, 0.f) & 0xffffu; }
__device__ __forceinline__ int pk_fp8(float a, float b, int old, bool hi) {
    a = __builtin_amdgcn_fmed3f(a, -448.0f, 448.0f); b = __builtin_amdgcn_fmed3f(b, -448.0f, 448.0f);
    return hi ? __builtin_amdgcn_cvt_pk_fp8_f32(a, b, old, true) : __builtin_amdgcn_cvt_pk_fp8_f32(a, b, old, false);
}
__device__ __forceinline__ float fast_rcp(float x) { return __builtin_amdgcn_rcpf(x); }
__device__ __forceinline__ float sigmoidf_(float v) { return fast_rcp(1.0f + __expf(-v)); }
__device__ __forceinline__ float siluf_(float v) { return v * sigmoidf_(v); }
__device__ __forceinline__ float wave_sum(float v) {
#pragma unroll
    for (int o = 1; o < 64; o <<= 1) v += __shfl_xor(v, o);
    return v;
}

#define XB_TMO      128
#define XB_XCNT(j)  (256  + 64 * (j))
#define XB_XSUB(j)  (1280 + 64 * (j))
#define XB_XGEN(j)  (2304 + 64 * (j))
#define XB_TOP      3328
#define XB_TOPGEN   3392
#define XCD_BAR_WORDS 3456
#define XB_SPIN_CAP (1u << 20)
__device__ __forceinline__ unsigned xb_ld(unsigned* p)              { return __hip_atomic_load(p, __ATOMIC_RELAXED, __HIP_MEMORY_SCOPE_AGENT); }
__device__ __forceinline__ unsigned xb_add(unsigned* p, unsigned v) { return __hip_atomic_fetch_add(p, v, __ATOMIC_RELAXED, __HIP_MEMORY_SCOPE_AGENT); }
__device__ __forceinline__ unsigned xb_xcc_id() { return (unsigned)__builtin_amdgcn_s_getreg((3 << 11) | 20) & 0xFu; }
#define XB_SPIN(cond, bar) do { unsigned _sp = 0; while (cond) { __builtin_amdgcn_s_sleep(1); \
    if ((++_sp & 255u) == 0u) { if (xb_ld(&(bar)[XB_TMO])) break; if (_sp > XB_SPIN_CAP) { atomicAdd(&(bar)[XB_TMO], 1u); break; } } } } while (0)
struct XcdBarrier { unsigned* bar; unsigned x; volatile LAS unsigned* st; };
__device__ __forceinline__ XcdBarrier xcd_barrier_post(unsigned* bar, volatile LAS unsigned* st) {
    XcdBarrier b; b.bar = bar; b.x = xb_xcc_id(); b.st = st;
    if (threadIdx.x == 0) (void)xb_add(&bar[XB_XCNT(b.x)], 1u);
    return b;
}
__device__ __forceinline__ void xcd_barrier_complete(unsigned* bar, unsigned x, unsigned& nloc, unsigned& nx) {
    const unsigned G = gridDim.x * gridDim.y * gridDim.z;
    unsigned sum, cnt, mine, sp = 0u;
    for (;;) {
        sum = 0u; cnt = 0u; mine = 0u;
#pragma unroll
        for (unsigned j = 0; j < 16; ++j) { const unsigned c = xb_ld(&bar[XB_XCNT(j)]); sum += c; cnt += (c > 0u) ? 1u : 0u; mine = (j == x) ? c : mine; }
        if (sum == G) break;
        __builtin_amdgcn_s_sleep(1);
        if ((++sp & 255u) == 0u) { if (xb_ld(&bar[XB_TMO])) break; if (sp > XB_SPIN_CAP) { atomicAdd(&bar[XB_TMO], 1u); break; } }
    }
    nloc = mine > 0u ? mine : 1u; nx = cnt > 0u ? cnt : 1u;
}
__device__ __forceinline__ void xcd_barrier(const XcdBarrier& b) {
    asm volatile("s_waitcnt vmcnt(0)" ::: "memory");
    __syncthreads();
    if (threadIdx.x == 0) {
        unsigned* bar = b.bar;
        __builtin_amdgcn_s_waitcnt(0);
        unsigned nloc = b.st[0], nx = b.st[1];
        if (nloc == 0u) { xcd_barrier_complete(bar, b.x, nloc, nx); b.st[0] = nloc; b.st[1] = nx; }
        const unsigned old = xb_add(&bar[XB_XSUB(b.x)], 1u);
        const unsigned gen = old / nloc;
        if (old + 1u == (gen + 1u) * nloc) {
            __builtin_amdgcn_fence(__ATOMIC_RELEASE, "agent");
            asm volatile("s_waitcnt vmcnt(0)" ::: "memory");
            const unsigned og = xb_add(&bar[XB_TOP], 1u);
            const unsigned tg = og / nx;
            if (og + 1u == (tg + 1u) * nx) xb_add(&bar[XB_TOPGEN], 1u);
            else XB_SPIN(xb_ld(&bar[XB_TOPGEN]) == tg, bar);
            __builtin_amdgcn_fence(__ATOMIC_ACQUIRE, "agent");
            xb_add(&bar[XB_XGEN(b.x)], 1u);
            asm volatile("s_waitcnt vmcnt(0)" ::: "memory");
        } else {
            XB_SPIN(xb_ld(&bar[XB_XGEN(b.x)]) == gen, bar);
            __builtin_amdgcn_fence(__ATOMIC_ACQUIRE, "agent");
            asm volatile("s_waitcnt vmcnt(0)" ::: "memory");
        }
    }
    __syncthreads();
}

__device__ __forceinline__ int opaque_tid() { int t = threadIdx.x; asm volatile("" : "+v"(t)); return t; }
#define PHASE_TID(F) do { const int t_ = opaque_tid(); (F).tid = t_; (F).lane = t_ & 63; (F).wave = __builtin_amdgcn_readfirstlane(t_ >> 6); unsigned long long z_ = 0; asm volatile("" : "+s"((F).bx), "+s"((F).G), "+s"(z_)); (F).ws = (F).ws0 + z_; } while (0)
struct Args { const float* in[17]; float* out; unsigned char* ws; int ph_lo, ph_hi; };
struct Frame {
    LAS unsigned char* lds;
    gu32* ctl;
    unsigned char* ws; unsigned char* ws0;
    int tid, lane, wave, G, bx;
    float* out;
};

namespace gm {
constexpr int BM = 256, BK = 64, HALF = 128, HTB = HALF * BK * 2, NXCD = 8, WGM = 8;
__host__ __device__ __forceinline__ int lds_byte(int r, int c) { const int st = (r >> 4) * 2 + (c >> 5), rr = r & 15, cc = c & 31, ob = rr * 64 + cc * 2; return st * 1024 + (ob ^ (((ob >> 9) & 1) << 5)); }
__host__ __device__ __forceinline__ void stage_rc(int b, int& R, int& C) { const int st = b / 1024, sb = b % 1024, swz = sb ^ (((sb >> 9) & 1) << 5); R = (st >> 1) * 16 + swz / 64; C = (st & 1) * 32 + (swz % 64) / 2; }
__host__ __device__ __forceinline__ int perm32(int rho) { const int n = rho >> 4, i = rho & 15; return 8 * (i >> 2) + 4 * n + (i & 3); }

struct Unit { int pm, pn, e, aux, cnt; };

struct Order {
    int nM, nN, nwg, G, c;
    __device__ __forceinline__ void init(int nM_, int nN_, int G_, int c_) { nM = nM_; nN = nN_; nwg = nM * nN; G = G_; c = c_; }
    __device__ __forceinline__ bool next(int i, int& pm, int& pn) const {
        const long L = (long)i * G + c; if (L >= nwg) return false;
        int wgid = (int)L; { const int q = nwg / NXCD, r = nwg % NXCD, xcd = wgid % NXCD, off = wgid / NXCD; wgid = (xcd < r ? xcd * (q + 1) : r * (q + 1) + (xcd - r) * q) + off; }
        const int nig = WGM * nN, gid = wgid / nig, fm = gid * WGM, gsz = (nM - fm) < WGM ? (nM - fm) : WGM;
        pm = fm + ((wgid % nig) % gsz); pn = (wgid % nig) / gsz; return true;
    }
};

struct PlainPolicy {
    Order o; const bf16* Bt;
    __device__ __forceinline__ bool next(int i, Unit& u) const { u.e = 0; u.aux = 0; u.cnt = 256; return o.next(i, u.pm, u.pn); }
    __device__ __forceinline__ unsigned arow(const Unit& u, int r) const { return (unsigned)(u.pm * 256 + r); }
    __device__ __forceinline__ const bf16* bbase(const Unit&) const { return Bt; }
};
constexpr int NVO_OFF = 131072 + 8192;
constexpr int TILE_TAB_OFF = 131072;
struct FfnPolicy {
    Order o; const bf16* W; size_t wstride;
    const int* list; int moe; int gatherA; int tile0; LAS const int* tab;
    __device__ __forceinline__ bool next(int i, Unit& u) const {
        if (!o.next(i, u.pm, u.pn)) return false;
        int e = 0, aux = u.pm * 256, cnt = 256;
        if (moe) { const int T = tile0 + u.pm;
            const int w0 = __builtin_amdgcn_readfirstlane(tab[2 * T]), w1 = __builtin_amdgcn_readfirstlane(tab[2 * T + 1]);
            e = w0 & 15; cnt = w0 >> 4; aux = w1; }
        u.e = e; u.aux = aux; u.cnt = cnt; return true;
    }
    __device__ __forceinline__ unsigned arow(const Unit& u, int r) const {
        if (!gatherA) return (unsigned)(u.pm * 256 + r);
        if (!moe) return (unsigned)(u.aux + r);
        return (r < u.cnt) ? ((unsigned)list[(size_t)u.e * M + u.aux + r] >> 1) : 0u;
    }
    __device__ __forceinline__ const bf16* bbase(const Unit& u) const { return W + (size_t)u.e * wstride; }
};
struct EpiPlain {
    bf16* O; int ldc;
    __device__ __forceinline__ void operator()(const f32x4 (&acc)[2][2][4][2], const Unit& u, int wr, int wc, int fr, int fq) const {
        const int row0 = u.pm * BM + wr * 64 + fr, col0 = u.pn * BM + wc * 32 + 8 * fq;
#pragma unroll
        for (int ai = 0; ai < 2; ++ai)
#pragma unroll
            for (int m = 0; m < 4; ++m) { bf16* rowp = O + (size_t)(row0 + ai * HALF + m * 16) * ldc + col0;
#pragma unroll
                for (int bj = 0; bj < 2; ++bj) { const f32x4 v0 = acc[ai][bj][m][0], v1 = acc[ai][bj][m][1];
                    u32x4 w; w.x = cvt_pk_bf16(v0[0], v0[1]); w.y = cvt_pk_bf16(v0[2], v0[3]); w.z = cvt_pk_bf16(v1[0], v1[1]); w.w = cvt_pk_bf16(v1[2], v1[3]);
                    *(u32x4*)(rowp + bj * HALF) = w; } }
    }
};
struct EpiInproj {
    bf16* O; const float* lb; const float* gain;
    __device__ __forceinline__ void operator()(const f32x4 (&acc)[2][2][4][2], const Unit& u, int wr, int wc, int fr, int fq) const {
        const int row0 = u.pm * BM + wr * 64 + fr, col0 = u.pn * BM + wc * 32 + 8 * fq;
        const int kind = u.pn >> 1;
        float aux[2][8];
#pragma unroll
        for (int bj = 0; bj < 2; ++bj)
#pragma unroll
            for (int j = 0; j < 8; ++j) aux[bj][j] = 0.f;
        if (kind == 1) {
#pragma unroll
            for (int bj = 0; bj < 2; ++bj)
#pragma unroll
                for (int j = 0; j < 8; ++j) aux[bj][j] = lb[col0 - C_HG + bj * HALF + j];
        } else if (kind == 3) {
#pragma unroll
            for (int bj = 0; bj < 2; ++bj)
#pragma unroll
                for (int j = 0; j < 8; ++j) aux[bj][j] = gain[col0 - C_HGATE + bj * HALF + j];
        }
#pragma unroll
        for (int ai = 0; ai < 2; ++ai)
#pragma unroll
            for (int m = 0; m < 4; ++m) { bf16* rowp = O + (size_t)(row0 + ai * HALF + m * 16) * NPROJ + col0;
#pragma unroll
                for (int bj = 0; bj < 2; ++bj) {
                    float v[8];
#pragma unroll
                    for (int j = 0; j < 4; ++j) { v[j] = acc[ai][bj][m][0][j]; v[4 + j] = acc[ai][bj][m][1][j]; }
                    if (kind == 0) {
#pragma unroll
                        for (int j = 0; j < 8; ++j) v[j] = siluf_(v[j]);
                    } else if (kind == 1) {
#pragma unroll
                        for (int j = 0; j < 8; ++j) { const float l = aux[bj][j]; const float f = l + (1.0f - l) * sigmoidf_(v[j]); v[j] = fmaxf(__logf(f), -60.0f); }
                    } else if (kind == 3) {
#pragma unroll
                        for (int j = 0; j < 8; ++j) v[j] = siluf_(v[j]) * aux[bj][j];
                    } else if (kind == 4) {
#pragma unroll
                        for (int j = 0; j < 8; ++j) v[j] *= (0.125f * LOG2E);
                    }
                    u32x4 w; w.x = cvt_pk_bf16(v[0], v[1]); w.y = cvt_pk_bf16(v[2], v[3]); w.z = cvt_pk_bf16(v[4], v[5]); w.w = cvt_pk_bf16(v[6], v[7]);
                    *(u32x4*)(rowp + bj * HALF) = w; } }
    }
};
struct EpiInproj8 {
    bf16* O; const float* lb; const float* gain; const float* sa; const float* wmax;
    template <int KIND>
    __device__ __forceinline__ void run(const f32x4 (&acc)[2][2][4][2], const Unit& u, int wr, int wc, int fr, int fq) const {
        const int row0 = u.pm * BM + wr * 64 + fr, col0 = u.pn * BM + wc * 32 + 8 * fq;
        const float sa_lo = sa[u.pm * BM + wr * 64 + fr + 16 * fq], sa_hi = sa[u.pm * BM + HALF + wr * 64 + fr + 16 * fq];
#pragma unroll
        for (int bj = 0; bj < 2; ++bj) {
            f32x2_t sc2[4], aux2[4];
#pragma unroll
            for (int j = 0; j < 4; ++j) {
                const float k0 = (KIND == 4) ? (0.125f * LOG2E / 127.0f) : (1.0f / 127.0f);
                sc2[j] = (f32x2_t){wmax[col0 + bj * HALF + 2 * j] * k0, wmax[col0 + bj * HALF + 2 * j + 1] * k0};
                if (KIND == 1) aux2[j] = (f32x2_t){lb[col0 - C_HG + bj * HALF + 2 * j], lb[col0 - C_HG + bj * HALF + 2 * j + 1]};
                else if (KIND == 3) aux2[j] = (f32x2_t){gain[col0 - C_HGATE + bj * HALF + 2 * j], gain[col0 - C_HGATE + bj * HALF + 2 * j + 1]};
                else aux2[j] = (f32x2_t){0.f, 0.f};
            }
#pragma unroll
            for (int ai = 0; ai < 2; ++ai)
#pragma unroll
                for (int m = 0; m < 4; ++m) { const int row = row0 + ai * HALF + m * 16; const float a = __shfl(ai ? sa_hi : sa_lo, 16 * m + fr);
                    const f32x4 f0 = __builtin_convertvector(__builtin_bit_cast(i32x4, acc[ai][bj][m][0]), f32x4), f1 = __builtin_convertvector(__builtin_bit_cast(i32x4, acc[ai][bj][m][1]), f32x4);
                    f32x2_t v[4] = {(f32x2_t){f0[0], f0[1]}, (f32x2_t){f0[2], f0[3]}, (f32x2_t){f1[0], f1[1]}, (f32x2_t){f1[2], f1[3]}};
#pragma unroll
                    for (int j = 0; j < 4; ++j) {
                        v[j] = v[j] * (sc2[j] * (f32x2_t){a, a});
                        if (KIND == 0 || KIND == 1 || KIND == 3) {
                            const f32x2_t e = v[j] * (f32x2_t){-LOG2E, -LOG2E};
                            const f32x2_t dn = (f32x2_t){__builtin_amdgcn_exp2f(e[0]), __builtin_amdgcn_exp2f(e[1])} + (f32x2_t){1.0f, 1.0f};
                            const f32x2_t sg = (f32x2_t){fast_rcp(dn[0]), fast_rcp(dn[1])};
                            if (KIND == 0) v[j] = v[j] * sg;
                            else if (KIND == 3) v[j] = (v[j] * sg) * aux2[j];
                            else { const f32x2_t f = __builtin_elementwise_fma((f32x2_t){1.0f, 1.0f} - aux2[j], sg, aux2[j]);
                                v[j] = (f32x2_t){fmaxf(__logf(f[0]), -60.0f), fmaxf(__logf(f[1]), -60.0f)}; }
                        }
                    }
                    u32x4 w; w.x = cvt_pk_bf16(v[0][0], v[0][1]); w.y = cvt_pk_bf16(v[1][0], v[1][1]); w.z = cvt_pk_bf16(v[2][0], v[2][1]); w.w = cvt_pk_bf16(v[3][0], v[3][1]);
                    *(u32x4*)(O + (size_t)row * NPROJ + col0 + bj * HALF) = w; }
        }
    }
    __device__ __forceinline__ void operator()(const f32x4 (&acc)[2][2][4][2], const Unit& u, int wr, int wc, int fr, int fq) const {
        const int kind = u.pn >> 1;
        if (kind == 0) run<0>(acc, u, wr, wc, fr, fq);
        else if (kind == 1) run<1>(acc, u, wr, wc, fr, fq);
        else if (kind == 3) run<3>(acc, u, wr, wc, fr, fq);
        else if (kind == 4) run<4>(acc, u, wr, wc, fr, fq);
        else run<2>(acc, u, wr, wc, fr, fq);
    }
};
struct EpiGU {
    bf16* H; int ldh;
    __device__ __forceinline__ void operator()(const f32x4 (&acc)[2][2][4][2], const Unit& u, int wr, int wc, int fr, int fq) const {
        const int row0 = u.pm * BM + wr * 64 + fr, col0 = u.pn * HALF + wc * 32 + 8 * fq;
#pragma unroll
        for (int ai = 0; ai < 2; ++ai)
#pragma unroll
            for (int m = 0; m < 4; ++m) { bf16* rowp = H + (size_t)(row0 + ai * HALF + m * 16) * ldh + col0;
                float v[8];
#pragma unroll
                for (int j = 0; j < 4; ++j) { v[j] = siluf_(acc[ai][0][m][0][j]) * acc[ai][1][m][0][j]; v[4 + j] = siluf_(acc[ai][0][m][1][j]) * acc[ai][1][m][1][j]; }
                u32x4 w; w.x = cvt_pk_bf16(v[0], v[1]); w.y = cvt_pk_bf16(v[2], v[3]); w.z = cvt_pk_bf16(v[4], v[5]); w.w = cvt_pk_bf16(v[6], v[7]);
                *(u32x4*)rowp = w; }
    }
};
struct EpiGU8 {
    unsigned char* H; int ldh;
    __device__ __forceinline__ void operator()(const f32x4 (&acc)[2][2][4][2], const Unit& u, int wr, int wc, int fr, int fq) const {
        const int row0 = u.pm * BM + wr * 64 + fr, col0 = u.pn * HALF + wc * 32 + 8 * fq;
        constexpr float isc = 1.0f / (H2_SCALE * WGU_SCALE);
        constexpr float IC = 1.0f / (isc * isc * HID_SCALE);
        static_assert(IC == 65536.0f, "log2(1/c) below assumes these scales");
        constexpr float LG_IC = 16.0f;
#pragma unroll
        for (int ai = 0; ai < 2; ++ai)
#pragma unroll
            for (int m = 0; m < 4; ++m) {
                unsigned char* rowp = H + (size_t)(row0 + ai * HALF + m * 16) * ldh + col0;
                float v[8];
#pragma unroll
                for (int n = 0; n < 2; ++n)
#pragma unroll
                    for (int h = 0; h < 2; ++h) {
                        const f32x2_t g2 = {acc[ai][0][m][n][2 * h], acc[ai][0][m][n][2 * h + 1]}, u2 = {acc[ai][1][m][n][2 * h], acc[ai][1][m][n][2 * h + 1]};
                        const f32x2_t gu = g2 * u2;
                        const f32x2_t ex = __builtin_elementwise_fma(g2, (f32x2_t){-isc * LOG2E, -isc * LOG2E}, (f32x2_t){LG_IC, LG_IC});
                        const f32x2_t dn = (f32x2_t){__builtin_amdgcn_exp2f(ex[0]), __builtin_amdgcn_exp2f(ex[1])} + (f32x2_t){IC, IC};
                        const f32x2_t o2 = gu * (f32x2_t){fast_rcp(dn[0]), fast_rcp(dn[1])};
                        v[4 * n + 2 * h] = o2[0]; v[4 * n + 2 * h + 1] = o2[1];
                    }
                int p0 = pk_fp8(v[0], v[1], 0, false); p0 = pk_fp8(v[2], v[3], p0, true);
                int p1 = pk_fp8(v[4], v[5], 0, false); p1 = pk_fp8(v[6], v[7], p1, true);
                *(u32x2*)rowp = (u32x2){(unsigned)p0, (unsigned)p1}; }
    }
};
struct EpiDown {
    bf16* Y; const int* list; int moe; float osc;
    __device__ __forceinline__ void operator()(const f32x4 (&acc)[2][2][4][2], const Unit& u, int wr, int wc, int fr, int fq) const {
        const int r0 = wr * 64 + fr, col0 = u.pn * BM + wc * 32 + 8 * fq;
#pragma unroll
        for (int ai = 0; ai < 2; ++ai)
#pragma unroll
            for (int m = 0; m < 4; ++m) { const int r = r0 + ai * HALF + m * 16;
                size_t drow; bool ok = true;
                if (moe) { ok = r < u.cnt; drow = ok ? (size_t)(unsigned)list[(size_t)u.e * M + u.aux + r] : 0; } else drow = (size_t)(u.pm * BM + r);
                bf16* rowp = Y + drow * D + col0;
#pragma unroll
                for (int bj = 0; bj < 2; ++bj) { const f32x4 v0 = acc[ai][bj][m][0] * osc, v1 = acc[ai][bj][m][1] * osc;
                    u32x4 w; w.x = cvt_pk_bf16(v0[0], v0[1]); w.y = cvt_pk_bf16(v0[2], v0[3]); w.z = cvt_pk_bf16(v1[0], v1[1]); w.w = cvt_pk_bf16(v1[2], v1[3]);
                    if (ok) *(u32x4*)(rowp + bj * HALF) = w; } }
    }
};

template <bool GATHER, class Epi, class Pol, int MODE = 0>
__device__ __forceinline__ void gemm_phase(LAS unsigned char* lds, const bf16* A, int K, const Pol& S, const Epi& E) {
    const int tid = opaque_tid(), wid = __builtin_amdgcn_readfirstlane(tid >> 6), lane = tid & 63, wr = wid >> 2, wc = wid & 3, fr = lane & 15, fq = lane >> 4;
    const int nt = K / BK;
    int R0, C0; stage_rc(tid * 16, R0, C0);
    const unsigned voffB0 = (unsigned)(((R0 & ~31) + perm32(R0 & 31)) * K + C0) * 2u, voffA0 = (unsigned)(R0 * K + C0) * 2u, vstep64 = (unsigned)(64 * K) * 2u;
    const size_t kstep = (size_t)(BK * 2);
    const size_t hstep = (size_t)HALF * K * 2;
    const size_t tstep = 2 * hstep;
    const unsigned ldsw = (unsigned)wid * 1024u;
    const int aoff = lds_byte(wr * 64 + fr, fq * 8), boff = lds_byte(wc * 32 + fr, fq * 8);
#define G_SA(b, h) (((b) * 2 + (h)) * HTB)
#define G_SB(b, h) ((4 + (b) * 2 + (h)) * HTB)
#define G_GLDS(gptr, ldsoff) __builtin_amdgcn_global_load_lds((const unsigned*)(gptr), (LAS unsigned*)(lds + (ldsoff)), 16, 0, 0)
#define G_STAGE_B(bufoff, gbase) do { G_GLDS((const char*)(gbase) + voffB0, (bufoff) + ldsw); G_GLDS((const char*)(gbase) + vstep64 + voffB0, (bufoff) + ldsw + 8192); } while (0)
#define G_STAGE_A(bufoff, kofs, v0, v1) do { G_GLDS((const char*)A + (kofs) + (v0), (bufoff) + ldsw); G_GLDS((const char*)A + (kofs) + (v1), (bufoff) + ldsw + 8192); } while (0)
#define G_STAGE_AU(bufoff, gbase) do { G_GLDS((const char*)(gbase) + voffA0, (bufoff) + ldsw); G_GLDS((const char*)(gbase) + vstep64 + voffA0, (bufoff) + ldsw + 8192); } while (0)
#define G_LDA(dst, b, h) do { _Pragma("unroll") for (int m = 0; m < 4; ++m) _Pragma("unroll") for (int k = 0; k < 2; ++k) dst[m][k] = *(const LAS bf16x8*)(lds + G_SA(b, h) + aoff + m * 2048 + k * 1024); } while (0)
#define G_LDB(dst, b, h) do { _Pragma("unroll") for (int n = 0; n < 2; ++n) _Pragma("unroll") for (int k = 0; k < 2; ++k) dst[n][k] = *(const LAS bf16x8*)(lds + G_SB(b, h) + boff + n * 2048 + k * 1024); } while (0)
#define G_MMA(ai, bj, At, Bt) do { __builtin_amdgcn_s_setprio(1); \
        _Pragma("unroll") for (int m = 0; m < 4; ++m) _Pragma("unroll") for (int n = 0; n < 2; ++n) _Pragma("unroll") for (int k = 0; k < 2; ++k) { \
            if constexpr (MODE == 1) acc[ai][bj][m][n] = __builtin_bit_cast(f32x4, __builtin_amdgcn_mfma_i32_16x16x64_i8(__builtin_bit_cast(i32x4, Bt[n][k]), __builtin_bit_cast(i32x4, At[m][k]), __builtin_bit_cast(i32x4, acc[ai][bj][m][n]), 0, 0, 0)); \
            else acc[ai][bj][m][n] = __builtin_amdgcn_mfma_f32_16x16x32_bf16(Bt[n][k], At[m][k], acc[ai][bj][m][n], 0, 0, 0); } \
        __builtin_amdgcn_s_setprio(0); } while (0)
#define G_LD8(p) __builtin_shufflevector(*(const LAS i32x4*)(p), *(const LAS i32x4*)((p) + 1024), 0, 1, 2, 3, 4, 5, 6, 7)
#define G_LDA8(dst, b, h) do { _Pragma("unroll") for (int m = 0; m < 4; ++m) dst[m] = G_LD8(lds + G_SA(b, h) + aoff + m * 2048); } while (0)
#define G_LDB8(dst, b, h) do { _Pragma("unroll") for (int n = 0; n < 2; ++n) dst[n] = G_LD8(lds + G_SB(b, h) + boff + n * 2048); } while (0)
#define G_MMA8(ai, bj, A8, B8) do { __builtin_amdgcn_s_setprio(1); _Pragma("unroll") for (int m = 0; m < 4; ++m) _Pragma("unroll") for (int n = 0; n < 2; ++n) \
        asm volatile("v_mfma_scale_f32_16x16x128_f8f6f4 %0, %1, %2, %0, %3, %3 op_sel_hi:[0,0,0]" : "+v"(acc[ai][bj][m][n]) : "v"(B8[n]), "v"(A8[m]), "v"(scl8)); __builtin_amdgcn_s_setprio(0); } while (0)
#define X_LDA(b, h) do { if constexpr (MODE == 2) G_LDA8(A8, b, h); else G_LDA(At, b, h); } while (0)
#define X_LDB0(b, h) do { if constexpr (MODE == 2) G_LDB8(B08, b, h); else G_LDB(B0, b, h); } while (0)
#define X_LDB1(b, h) do { if constexpr (MODE == 2) G_LDB8(B18, b, h); else G_LDB(B1, b, h); } while (0)
#define X_MMA0(ai, bj) do { if constexpr (MODE == 2) G_MMA8(ai, bj, A8, B08); else G_MMA(ai, bj, At, B0); } while (0)
#define X_MMA1(ai, bj) do { if constexpr (MODE == 2) G_MMA8(ai, bj, A8, B18); else G_MMA(ai, bj, At, B1); } while (0)
#define G_WAIT_V(n) asm volatile("s_waitcnt vmcnt(" #n ")" ::: "memory")
#define G_WAIT_L(n) asm volatile("s_waitcnt lgkmcnt(" #n ")" ::: "memory")
#define G_BAR __builtin_amdgcn_s_barrier()
#define G_SCHED __builtin_amdgcn_sched_barrier(0)
#define G_VOA(dst, u) do { _Pragma("unroll") for (int h = 0; h < 2; ++h) _Pragma("unroll") for (int i = 0; i < 2; ++i) dst[h][i] = (S.arow(u, h * HALF + R0 + 64 * i) * (unsigned)K + (unsigned)C0) * 2u; } while (0)
    Unit cur, nxt; int ui = 0;
    if (!S.next(0, cur)) return;
    f32x4 acc[2][2][4][2];
#pragma unroll
    for (int a = 0; a < 2; ++a)
#pragma unroll
        for (int b = 0; b < 2; ++b)
#pragma unroll
            for (int m = 0; m < 4; ++m)
#pragma unroll
                for (int n = 0; n < 2; ++n) acc[a][b][m][n] = (f32x4){0.f, 0.f, 0.f, 0.f};
    bf16x8 At[4][2], B0[2][2], B1[2][2];
    i32x8 A8[4], B08[2], B18[2];
    const int scl8 = 0x7f7f7f7f;
    const char* cB = (const char*)S.bbase(cur) + (size_t)cur.pn * tstep;
    if constexpr (GATHER) {
    unsigned vo[2][2];
    LAS u32x4* nvo_l = (LAS u32x4*)(lds + NVO_OFF) + tid;
    G_VOA(vo, cur);
    G_STAGE_B(G_SB(0, 0), cB); G_STAGE_B(G_SB(0, 1), cB + hstep); G_STAGE_A(G_SA(0, 0), 0, vo[0][0], vo[0][1]); G_STAGE_A(G_SA(0, 1), 0, vo[1][0], vo[1][1]);
    if (wr == 1) G_BAR;
    G_WAIT_V(2); G_BAR;
    G_STAGE_B(G_SB(1, 0), cB + kstep); G_STAGE_A(G_SA(1, 0), kstep, vo[0][0], vo[0][1]); G_STAGE_B(G_SB(1, 1), cB + hstep + kstep);
    G_WAIT_V(6); G_BAR;
    for (;;) {
        const bool has_next = S.next(ui + 1, nxt);
        const char* nB = cB;
        { unsigned nvo[2][2];
          if (has_next) { G_VOA(nvo, nxt); nB = (const char*)S.bbase(nxt) + (size_t)nxt.pn * tstep; }
          else {
#pragma unroll
            for (int h = 0; h < 2; ++h)
#pragma unroll
                for (int i = 0; i < 2; ++i) nvo[h][i] = vo[h][i];
          }
          *nvo_l = (u32x4){nvo[0][0], nvo[0][1], nvo[1][0], nvo[1][1]}; }
        for (int t = 0; t < nt; t += 2) {
            const bool last = (t == nt - 2);
            const size_t k1 = (size_t)(t + 1) * kstep;
            const size_t k2 = last ? 0 : (size_t)(t + 2) * kstep;
            const char* b2 = last ? nB : cB + (size_t)(t + 2) * kstep;
            const char* b3 = b2 + kstep;
            unsigned w00 = vo[0][0], w01 = vo[0][1], w10 = vo[1][0], w11 = vo[1][1];
            if (last) { const u32x4 nv = *nvo_l; w00 = nv[0]; w01 = nv[1]; w10 = nv[2]; w11 = nv[3]; }
            X_LDB0(0, 0); X_LDB1(0, 1); G_SCHED; X_LDA(0, 0); G_STAGE_A(G_SA(1, 1), k1, vo[1][0], vo[1][1]);
            G_WAIT_V(8); G_WAIT_L(0); G_BAR; X_MMA0(0, 0); X_MMA1(0, 1); G_BAR; G_SCHED;
            X_LDA(0, 1); G_STAGE_B(G_SB(0, 0), b2); G_STAGE_B(G_SB(0, 1), b2 + hstep); G_STAGE_A(G_SA(0, 0), k2, w00, w01);
            G_WAIT_V(8); G_WAIT_L(0); G_BAR; X_MMA0(1, 0); X_MMA1(1, 1); G_BAR; G_SCHED;
            X_LDB0(1, 0); X_LDB1(1, 1); G_SCHED; X_LDA(1, 0); G_STAGE_A(G_SA(0, 1), k2, w10, w11);
            G_WAIT_V(8); G_WAIT_L(0); G_BAR; X_MMA0(0, 0); X_MMA1(0, 1); G_BAR; G_SCHED;
            X_LDA(1, 1); G_STAGE_B(G_SB(1, 0), b3); G_STAGE_B(G_SB(1, 1), b3 + hstep); G_STAGE_A(G_SA(1, 0), k2 + kstep, w00, w01);
            G_WAIT_V(8); G_WAIT_L(0); G_BAR; X_MMA0(1, 0); X_MMA1(1, 1); G_BAR; G_SCHED;
        }
        if (wr == 0) G_BAR;
        E(acc, cur, wr, wc, fr, fq);
        if (!has_next) break;
#pragma unroll
        for (int a = 0; a < 2; ++a)
#pragma unroll
            for (int b = 0; b < 2; ++b)
#pragma unroll
                for (int m = 0; m < 4; ++m)
#pragma unroll
                    for (int n = 0; n < 2; ++n) acc[a][b][m][n] = (f32x4){0.f, 0.f, 0.f, 0.f};
        cur = nxt; cB = nB; ++ui;
        { const u32x4 nv = *nvo_l; vo[0][0] = nv[0]; vo[0][1] = nv[1]; vo[1][0] = nv[2]; vo[1][1] = nv[3]; }
        if (wr == 1) G_BAR;
    }
    } else {
    const char* cA = (const char*)A + (size_t)S.arow(cur, 0) * (size_t)K * 2;
    G_STAGE_B(G_SB(0, 0), cB); G_STAGE_B(G_SB(0, 1), cB + hstep); G_STAGE_AU(G_SA(0, 0), cA); G_STAGE_AU(G_SA(0, 1), cA + hstep);
    if (wr == 1) G_BAR;
    G_WAIT_V(2); G_BAR;
    G_STAGE_B(G_SB(1, 0), cB + kstep); G_STAGE_AU(G_SA(1, 0), cA + kstep); G_STAGE_B(G_SB(1, 1), cB + hstep + kstep);
    G_WAIT_V(6); G_BAR;
    for (;;) {
        const bool has_next = S.next(ui + 1, nxt);
        const char* nA = has_next ? (const char*)A + (size_t)S.arow(nxt, 0) * (size_t)K * 2 : cA; const char* nB = has_next ? (const char*)S.bbase(nxt) + (size_t)nxt.pn * tstep : cB;
        for (int t = 0; t < nt; t += 2) {
            const bool last = (t == nt - 2);
            const char* a1 = cA + (size_t)(t + 1) * kstep;
            const char* a2 = last ? nA : cA + (size_t)(t + 2) * kstep; const char* b2 = last ? nB : cB + (size_t)(t + 2) * kstep;
            const char* a3 = a2 + kstep; const char* b3 = b2 + kstep;
            X_LDB0(0, 0); X_LDB1(0, 1); G_SCHED; X_LDA(0, 0); G_STAGE_AU(G_SA(1, 1), a1 + hstep);
            G_WAIT_V(8); G_WAIT_L(0); G_BAR; X_MMA0(0, 0); X_MMA1(0, 1); G_BAR; G_SCHED;
            X_LDA(0, 1); G_STAGE_B(G_SB(0, 0), b2); G_STAGE_B(G_SB(0, 1), b2 + hstep); G_STAGE_AU(G_SA(0, 0), a2);
            G_WAIT_V(8); G_WAIT_L(0); G_BAR; X_MMA0(1, 0); X_MMA1(1, 1); G_BAR; G_SCHED;
            X_LDB0(1, 0); X_LDB1(1, 1); G_SCHED; X_LDA(1, 0); G_STAGE_AU(G_SA(0, 1), a2 + hstep);
            G_WAIT_V(8); G_WAIT_L(0); G_BAR; X_MMA0(0, 0); X_MMA1(0, 1); G_BAR; G_SCHED;
            X_LDA(1, 1); G_STAGE_B(G_SB(1, 0), b3); G_STAGE_B(G_SB(1, 1), b3 + hstep); G_STAGE_AU(G_SA(1, 0), a3);
            G_WAIT_V(8); G_WAIT_L(0); G_BAR; X_MMA0(1, 0); X_MMA1(1, 1); G_BAR; G_SCHED;
        }
        if (wr == 0) G_BAR;
        E(acc, cur, wr, wc, fr, fq);
        if (!has_next) break;
#pragma unroll
        for (int a = 0; a < 2; ++a)
#pragma unroll
            for (int b = 0; b < 2; ++b)
#pragma unroll
                for (int m = 0; m < 4; ++m)
#pragma unroll
                    for (int n = 0; n < 2; ++n) acc[a][b][m][n] = (f32x4){0.f, 0.f, 0.f, 0.f};
        cur = nxt; cA = nA; cB = nB; ++ui;
        if (wr == 1) G_BAR;
    }
    }
    G_WAIT_V(0);
    G_BAR;
#undef G_SA
#undef G_SB
#undef G_GLDS
#undef G_STAGE_A
#undef G_STAGE_AU
#undef G_STAGE_B
#undef G_LDA
#undef G_LDB
#undef G_MMA
#undef G_LD8
#undef G_LDA8
#undef G_LDB8
#undef G_MMA8
#undef X_LDA
#undef X_LDB0
#undef X_LDB1
#undef X_MMA0
#undef X_MMA1
#undef G_WAIT_V
#undef G_WAIT_L
#undef G_BAR
#undef G_SCHED
#undef G_VOA
}
}

__device__ __forceinline__ void transpose_item(const float* W, int K, int N, bf16* WT, int row_off, int ileave, LAS float* scr, int item, int lane) {
    const int nblk = N / 32, kb = item / nblk, nb = item % nblk, k0 = 64 * kb, n0 = 32 * nb;
#pragma unroll
    for (int i = 0; i < 32; ++i) { const int kk = 2 * i + (lane >> 5); scr[kk * 33 + (lane & 31)] = W[(size_t)(k0 + kk) * N + n0 + (lane & 31)]; }
    LDS_WAIT(); asm volatile("" ::: "memory");
    const int c = lane & 7;
    const int drow0 = row_off + (ileave ? (((n0 >> 7) << 8) + (n0 & 127)) : n0);
#pragma unroll
    for (int j = 0; j < 4; ++j) { const int n = (lane >> 3) + 8 * j; const LAS float* s = scr + (8 * c) * 33 + n;
        u32x4 o; o.x = pk2(s[0 * 33], s[1 * 33]); o.y = pk2(s[2 * 33], s[3 * 33]); o.z = pk2(s[4 * 33], s[5 * 33]); o.w = pk2(s[6 * 33], s[7 * 33]);
        *(GAS u32x4*)(WT + (size_t)(drow0 + n) * K + k0 + 8 * c) = o; }
    LDS_WAIT(); asm volatile("" ::: "memory");
}
__device__ __forceinline__ void transpose8_item(const float* W, int K, int N, unsigned char* WT, int row_off, int ileave, float wsc, LAS float* scr, int item, int lane) {
    const int nblk = N / 32, kb = item / nblk, nb = item % nblk, k0 = 64 * kb, n0 = 32 * nb;
#pragma unroll
    for (int i = 0; i < 32; ++i) { const int kk = 2 * i + (lane >> 5); scr[kk * 33 + (lane & 31)] = W[(size_t)(k0 + kk) * N + n0 + (lane & 31)]; }
    LDS_WAIT(); asm volatile("" ::: "memory");
    const int c = lane & 3;
    const int drow0 = row_off + (ileave ? (((n0 >> 7) << 8) + (n0 & 127)) : n0);
#pragma unroll
    for (int j = 0; j < 2; ++j) { const int n = (lane >> 2) + 16 * j; const LAS float* sp = scr + (16 * c) * 33 + n;
        unsigned w[4];
#pragma unroll
        for (int q = 0; q < 4; ++q) { int p = pk_fp8(sp[(4 * q) * 33] * wsc, sp[(4 * q + 1) * 33] * wsc, 0, false);
            p = pk_fp8(sp[(4 * q + 2) * 33] * wsc, sp[(4 * q + 3) * 33] * wsc, p, true); w[q] = (unsigned)p; }
        *(GAS u32x4*)(WT + (size_t)(drow0 + n) * K + k0 + 16 * c) = (u32x4){w[0], w[1], w[2], w[3]}; }
    LDS_WAIT(); asm volatile("" ::: "memory");
}
__device__ __forceinline__ void absmax_item(const float* W, int N, gu32* wmax, int item, int lane) {
    const int nblk = N / 32, kb = item / nblk, nb = item % nblk, k0 = 64 * kb, n0 = 32 * nb;
    float v[32];
#pragma unroll
    for (int i = 0; i < 32; ++i) { const int kk = 2 * i + (lane >> 5); v[i] = W[(size_t)(k0 + kk) * N + n0 + (lane & 31)]; }
    float am = 0.f;
#pragma unroll
    for (int i = 0; i < 32; ++i) am = fmaxf(am, fabsf(v[i]));
    am = fmaxf(am, __shfl_xor(am, 32));
    if (lane < 32) __hip_atomic_fetch_max((unsigned*)(wmax + n0 + lane), __builtin_bit_cast(unsigned, am), RLX_AGENT);
}
__device__ __forceinline__ void quant8_item(const float* W, int K, int N, signed char* WT, const gu32* wmax, LAS float* scr, int item, int lane) {
    const int nblk = N / 32, kb = item / nblk, nb = item % nblk, k0 = 64 * kb, n0 = 32 * nb;
#pragma unroll
    for (int i = 0; i < 32; ++i) { const int kk = 2 * i + (lane >> 5); scr[kk * 33 + (lane & 31)] = W[(size_t)(k0 + kk) * N + n0 + (lane & 31)]; }
    LDS_WAIT(); asm volatile("" ::: "memory");
    const int c = lane & 3;
#pragma unroll
    for (int j = 0; j < 2; ++j) { const int n = (lane >> 2) + 16 * j; const LAS float* sp = scr + (16 * c) * 33 + n;
        const float am = __builtin_bit_cast(float, __hip_atomic_load((unsigned*)(wmax + n0 + n), RLX_AGENT));
        const float inv = 127.0f / fmaxf(am, 1e-30f);
        unsigned w[4];
#pragma unroll
        for (int q = 0; q < 4; ++q) { unsigned pk = 0;
#pragma unroll
            for (int i = 0; i < 4; ++i) pk |= ((unsigned)(int)rintf(sp[(4 * q + i) * 33] * inv) & 0xffu) << (8 * i);
            w[q] = pk; }
        *(GAS u32x4*)(WT + (size_t)(n0 + n) * K + k0 + 16 * c) = (u32x4){w[0], w[1], w[2], w[3]}; }
    LDS_WAIT(); asm volatile("" ::: "memory");
}
__device__ __forceinline__ void conv_win(Frame& F, const Args& args, int layer) {
    PHASE_TID(F);
    LAS float* scr = (LAS float*)(F.lds + F.wave * 16384);
    const int gw = F.bx * NWAVES + F.wave, NGW = F.G * NWAVES;
    constexpr int I_IN = (D / 64) * (NPROJ / 32);
    for (int it = gw; it < I_IN; it += NGW) quant8_item(args.in[4] + (size_t)layer * D * NPROJ, D, NPROJ, (signed char*)(F.ws + WS_WIN), F.ctl + CW_WMAX + layer * NPROJ, scr, it, F.lane);
}
__device__ __forceinline__ void win_absmax_all(Frame& F, const Args& args) {
    PHASE_TID(F);
    const int gw = F.bx * NWAVES + F.wave, NGW = F.G * NWAVES;
    constexpr int I_IN = (D / 64) * (NPROJ / 32);
    float rg[32];
#define AM_LOAD(itv, dst) do { const int l_ = (itv) / I_IN, r_ = (itv) % I_IN, kb_ = r_ / (NPROJ / 32), nb_ = r_ % (NPROJ / 32); \
        const float* wp_ = args.in[4] + (size_t)l_ * D * NPROJ + (size_t)(64 * kb_ + (F.lane >> 5)) * NPROJ + 32 * nb_ + (F.lane & 31); \
        _Pragma("unroll") for (int i_ = 0; i_ < 32; ++i_) dst[i_] = wp_[(size_t)(2 * i_) * NPROJ]; } while (0)
    if (gw < DEPTH * I_IN) AM_LOAD(gw, rg);
    for (int it = gw; it < DEPTH * I_IN; it += NGW) {
        float nrg[32]; const bool hn = it + NGW < DEPTH * I_IN;
        if (hn) AM_LOAD(it + NGW, nrg);
        const int l = it / I_IN, r = it % I_IN, nb = r % (NPROJ / 32);
        float am = 0.f;
#pragma unroll
        for (int i = 0; i < 32; ++i) am = fmaxf(am, fabsf(rg[i]));
        am = fmaxf(am, __shfl_xor(am, 32));
        if (F.lane < 32) __hip_atomic_fetch_max((unsigned*)(F.ctl + CW_WMAX + l * NPROJ + 32 * nb + F.lane), __builtin_bit_cast(unsigned, am), RLX_AGENT);
        if (hn) {
#pragma unroll
            for (int i = 0; i < 32; ++i) rg[i] = nrg[i]; }
    }
#undef AM_LOAD
}
struct ConvItem { const float* W; unsigned char* WT; int K, N, row_off, ileave, kind, item; float wsc; };
#define CONV_LOAD(ci, rg) do { const int nblk_ = (ci).N / 32, kb_ = (ci).item / nblk_, nb_ = (ci).item % nblk_; const float* wp_ = (ci).W + (size_t)(64 * kb_ + (F.lane >> 5)) * (ci).N + 32 * nb_ + (F.lane & 31); \
        _Pragma("unroll") for (int i_ = 0; i_ < 32; ++i_) rg[i_] = wp_[(size_t)(2 * i_) * (ci).N]; } while (0)
__device__ __forceinline__ void conv_finish(const ConvItem& ci, const float (&rg)[32], LAS float* scr, int lane) {
    const int nblk = ci.N / 32, kb = ci.item / nblk, nb = ci.item % nblk, k0 = 64 * kb, n0 = 32 * nb;
#pragma unroll
    for (int i = 0; i < 32; ++i) { const int kk = 2 * i + (lane >> 5); scr[kk * 33 + (lane & 31)] = rg[i]; }
    LDS_WAIT(); asm volatile("" ::: "memory");
    const int drow0 = ci.row_off + (ci.ileave ? (((n0 >> 7) << 8) + (n0 & 127)) : n0);
    if (ci.kind == 0) {
        const int c = lane & 7; bf16* WT = (bf16*)ci.WT;
#pragma unroll
        for (int j = 0; j < 4; ++j) { const int n = (lane >> 3) + 8 * j; const LAS float* sp = scr + (8 * c) * 33 + n;
            u32x4 o; o.x = pk2(sp[0 * 33], sp[1 * 33]); o.y = pk2(sp[2 * 33], sp[3 * 33]); o.z = pk2(sp[4 * 33], sp[5 * 33]); o.w = pk2(sp[6 * 33], sp[7 * 33]);
            *(GAS u32x4*)(WT + (size_t)(drow0 + n) * ci.K + k0 + 8 * c) = o; }
    } else {
        const int c = lane & 3; const float wsc = ci.wsc;
#pragma unroll
        for (int j = 0; j < 2; ++j) { const int n = (lane >> 2) + 16 * j; const LAS float* sp = scr + (16 * c) * 33 + n;
            unsigned w[4];
#pragma unroll
            for (int q = 0; q < 4; ++q) { int pq = pk_fp8(sp[(4 * q) * 33] * wsc, sp[(4 * q + 1) * 33] * wsc, 0, false);
                pq = pk_fp8(sp[(4 * q + 2) * 33] * wsc, sp[(4 * q + 3) * 33] * wsc, pq, true); w[q] = (unsigned)pq; }
            *(GAS u32x4*)(ci.WT + (size_t)(drow0 + n) * ci.K + k0 + 16 * c) = (u32x4){w[0], w[1], w[2], w[3]}; }
    }
    LDS_WAIT(); asm volatile("" ::: "memory");
}
__device__ __forceinline__ void conv_layer(Frame& F, const Args& args, int layer) {
    PHASE_TID(F);
    LAS float* scr = (LAS float*)(F.lds + F.wave * 16384);
    const int gw = F.bx * NWAVES + F.wave, NGW = F.G * NWAVES;
    unsigned char* WOUT = (unsigned char*)(F.ws + WS_WOUT); unsigned char* WDN = (unsigned char*)(F.ws + WS_WDN); unsigned char* WGU8 = (unsigned char*)(F.ws + WS_WGU);
    const int j = layer >> 1, moe = layer & 1;
    constexpr int I_OUT = (D / 64) * (D / 32);
    constexpr int I_QD = (D / 64) * (DFF / 32), I_DD = (DFF / 64) * (D / 32);
    constexpr int I_QE = (D / 64) * (DFFE / 32), I_DE = (DFFE / 64) * (D / 32);
    const int NIT = moe ? (NE * 2 * I_QE + I_OUT + NE * I_DE) : (2 * I_QD + I_OUT + I_DD);
    auto decode = [&](int it) __attribute__((always_inline)) -> ConvItem {
        ConvItem ci; int r = it;
        if (!moe) {
            if (r < 2 * I_QD) { const int up = r >= I_QD; ci = ConvItem{(up ? args.in[9] : args.in[8]) + (size_t)j * D * DFF, WGU8, D, DFF, up ? 128 : 0, 1, 1, up ? r - I_QD : r, WGU_SCALE}; return ci; } r -= 2 * I_QD;
            if (r < I_OUT) { ci = ConvItem{args.in[5] + (size_t)layer * D * D, WOUT, D, D, 0, 0, 0, r, 1.0f}; return ci; } r -= I_OUT;
            ci = ConvItem{args.in[10] + (size_t)j * DFF * D, WDN, DFF, D, 0, 0, 1, r, WDN_SCALE}; return ci;
        }
        if (r < NE * 2 * I_QE) { const int e = r / (2 * I_QE), q = r % (2 * I_QE), up = q >= I_QE; const size_t we = ((size_t)j * NE + e) * (size_t)D * DFFE;
            ci = ConvItem{(up ? args.in[13] : args.in[12]) + we, WGU8 + (size_t)e * 2 * DFFE * D, D, DFFE, up ? 128 : 0, 1, 1, up ? q - I_QE : q, WGU_SCALE}; return ci; } r -= NE * 2 * I_QE;
        if (r < I_OUT) { ci = ConvItem{args.in[5] + (size_t)layer * D * D, WOUT, D, D, 0, 0, 0, r, 1.0f}; return ci; } r -= I_OUT;
        const int e = r / I_DE; r -= e * I_DE; const size_t we = ((size_t)j * NE + e) * (size_t)D * DFFE;
        ci = ConvItem{args.in[14] + we, WDN + (size_t)e * D * DFFE, DFFE, D, 0, 0, 1, r, WDN_SCALE}; return ci;
    };
    ConvItem cur; float rg[32];
    if (gw < NIT) { cur = decode(gw); CONV_LOAD(cur, rg); }
    for (int it = gw; it < NIT; it += NGW) {
        ConvItem nxt; float nrg[32]; const bool hn = it + NGW < NIT;
        if (hn) { nxt = decode(it + NGW); CONV_LOAD(nxt, nrg); }
        conv_finish(cur, rg, scr, F.lane);
        if (hn) { cur = nxt;
#pragma unroll
            for (int i = 0; i < 32; ++i) rg[i] = nrg[i]; }
    }
}
__device__ __forceinline__ void pre_phase(Frame& F, const Args& args) {
    PHASE_TID(F);
    LAS float* sc = (LAS float*)F.lds;
    LAS float* red = (LAS float*)(F.lds + 65536);
    const float* c = args.in[1];
    for (int i = F.tid; i < NB * D; i += NTHR) { const int b = i >> 10, k = i & 1023; sc[k * 16 + b] = siluf_(c[i]); }
    __syncthreads();
    float* mod = (float*)(F.ws + WS_MOD);
    for (int item = F.bx; item < 8 * 48; item += F.G) {
        const int ls = item / 48, j0 = (item % 48) * 64;
        const float* W = args.in[2] + (size_t)ls * D * 3072;
        float a[16];
#pragma unroll
        for (int b = 0; b < 16; ++b) a[b] = 0.f;
        const int kb = F.wave * 128;
#pragma unroll 4
        for (int k = 0; k < 128; ++k) {
            const float w = W[(size_t)(kb + k) * 3072 + j0 + F.lane];
            const LAS f32x4* s4 = (const LAS f32x4*)(sc + (kb + k) * 16);
#pragma unroll
            for (int q = 0; q < 4; ++q) { const f32x4 s = s4[q]; a[4 * q + 0] += s[0] * w; a[4 * q + 1] += s[1] * w; a[4 * q + 2] += s[2] * w; a[4 * q + 3] += s[3] * w; }
        }
#pragma unroll
        for (int b = 0; b < 16; ++b) red[(F.wave * 16 + b) * 64 + F.lane] = a[b];
        __syncthreads();
        for (int o = F.tid; o < 1024; o += NTHR) { const int b = o >> 6, jj = o & 63; float s = 0.f;
#pragma unroll
            for (int w = 0; w < 8; ++w) s += red[(w * 16 + b) * 64 + jj];
            mod[((size_t)ls * NB + b) * 3072 + j0 + jj] = s + args.in[3][(size_t)ls * 3072 + j0 + jj]; }
        __syncthreads();
    }
    if (F.bx == 0) {
        float* lbo = (float*)(F.ws + WS_LB); const float* lg = args.in[6];
        const int j = F.tid;
        const float l0 = lg[j], l1 = lg[512 + j], l2 = lg[1024 + j], l3 = lg[1536 + j];
        const float mx = fmaxf(fmaxf(l0, l1), fmaxf(l2, l3));
        const float e0 = expf(l0 - mx), e1 = expf(l1 - mx), e2 = expf(l2 - mx), e3 = expf(l3 - mx), inv = 1.0f / (e0 + e1 + e2 + e3);
        lbo[j] = 0.f; lbo[512 + j] = e1 * inv; lbo[1024 + j] = (e1 + e2) * inv; lbo[1536 + j] = (e1 + e2 + e3) * inv;
    }
}
__device__ __forceinline__ void h_store_i8(const f32x4 (&hv)[4], float am, signed char* dst, float* scl_out, int lane) {
#pragma unroll
    for (int o = 1; o < 64; o <<= 1) am = fmaxf(am, __shfl_xor(am, o));
    const float scl = fmaxf(am, 1e-30f) * (1.0f / 127.0f), inv = 1.0f / scl;
    unsigned* q8 = (unsigned*)dst;
#pragma unroll
    for (int jj = 0; jj < 4; ++jj) { unsigned pk = 0;
#pragma unroll
        for (int i = 0; i < 4; ++i) pk |= ((unsigned)(int)rintf(hv[jj][i] * inv) & 0xffu) << (8 * i);
        q8[64 * jj] = pk; }
    if (lane == 0) *scl_out = scl;
}
__device__ __forceinline__ void h0_phase(Frame& F, const Args& args) {
    PHASE_TID(F);
    const int gw = F.bx * NWAVES + F.wave, NGW = F.G * NWAVES;
    const float* mod = (const float*)(F.ws + WS_MOD); bf16* HB = (bf16*)(F.ws + WS_HB);
    for (int blk = gw; blk < M / 32; blk += NGW) {
        const int row0 = blk * 32, b = row0 / SEQ;
        const float* mb = mod + ((size_t)(0 * 2 + 0) * NB + b) * 3072;
        f32x4 sh[4], sc[4];
#pragma unroll
        for (int jj = 0; jj < 4; ++jj) { sh[jj] = *(const f32x4*)(mb + 4 * F.lane + 256 * jj); sc[jj] = *(const f32x4*)(mb + 1024 + 4 * F.lane + 256 * jj); }
        const float* xr0 = args.in[0] + (size_t)row0 * D + 4 * F.lane;
        f32x4 xa[4], xb[4];
#pragma unroll
        for (int jj = 0; jj < 4; ++jj) { xa[jj] = __builtin_nontemporal_load((const f32x4*)(xr0 + 256 * jj)); xb[jj] = __builtin_nontemporal_load((const f32x4*)(xr0 + D + 256 * jj)); }
        for (int r = 0; r < 32; r += 2) {
#pragma unroll
            for (int half = 0; half < 2; ++half) {
                f32x4 hv[4]; float am = 0.f;
#pragma unroll
                for (int jj = 0; jj < 4; ++jj) { const f32x4 v = half ? xb[jj] : xa[jj]; hv[jj] = v * (1.0f + sc[jj]) + sh[jj];
                    am = fmaxf(fmaxf(am, fmaxf(fabsf(hv[jj][0]), fabsf(hv[jj][1]))), fmaxf(fabsf(hv[jj][2]), fabsf(hv[jj][3]))); }
                if (r + 2 < 32) {
#pragma unroll
                    for (int jj = 0; jj < 4; ++jj) { const f32x4 t = __builtin_nontemporal_load((const f32x4*)(xr0 + (size_t)(r + 2 + half) * D + 256 * jj)); if (half) xb[jj] = t; else xa[jj] = t; }
                }
                h_store_i8(hv, am, (signed char*)HB + (size_t)(row0 + r + half) * D + 4 * F.lane, (float*)(F.ws + WS_HSC) + row0 + r + half, F.lane);
            }
        }
    }
}
template <int MODE, bool ROUTE, int H8>
__device__ __forceinline__ void ln_phase(Frame& F, const float* xsrc  , bool xin16  , bool xout16  , const bf16* Y, const float* gate_mod  , const float* lng, const float* lnb,
                                         const float* next_mod  , const float* wrouter, int jm) {
    PHASE_TID(F);
    _Float16* XH = (_Float16*)(F.ws + WS_XH);
    const int gw = F.bx * NWAVES + F.wave, NGW = F.G * NWAVES;
    bf16* HB = (bf16*)(F.ws + WS_HB);
    unsigned* route = (unsigned*)(F.ws + WS_ROUTE);
    LAS float* wr_l = (LAS float*)F.lds;
    LAS int* lcnt = (LAS int*)(F.lds + 32768);
    LAS int* llist = (LAS int*)(F.lds + 32768 + 256);
    if (ROUTE) {
        for (int i = F.tid; i < D * NE; i += NTHR) wr_l[i] = wrouter[i];
        if (F.tid < 16) lcnt[F.tid] = 0;
        __syncthreads();
    }
    f32x4 g4[4], b4[4];
#pragma unroll
    for (int jj = 0; jj < 4; ++jj) { g4[jj] = *(const f32x4*)(lng + 4 * F.lane + 256 * jj); b4[jj] = *(const f32x4*)(lnb + 4 * F.lane + 256 * jj); }
    for (int blk = gw; blk < M / 32; blk += NGW) {
        const int row0 = blk * 32, b = row0 / SEQ;
        f32x4 gt[4], nsh[4], nsc[4];
#pragma unroll
        for (int jj = 0; jj < 4; ++jj) { gt[jj] = *(const f32x4*)(gate_mod + (size_t)b * 3072 + 2048 + 4 * F.lane + 256 * jj);
            if (next_mod) { nsh[jj] = *(const f32x4*)(next_mod + (size_t)b * 3072 + 4 * F.lane + 256 * jj); nsc[jj] = *(const f32x4*)(next_mod + (size_t)b * 3072 + 1024 + 4 * F.lane + 256 * jj); }
            else { nsh[jj] = (f32x4){0.f, 0.f, 0.f, 0.f}; nsc[jj] = nsh[jj]; } }
        f32x4 xq[4]; u32x2 xhq[4], yq0[4], yq1[4];
#define LN_LOAD(rr) do { const int row_ = row0 + (rr); const float* xr_ = xsrc + (size_t)row_ * D + 4 * F.lane; const _Float16* xh_ = XH + (size_t)row_ * D + 4 * F.lane; \
            _Pragma("unroll") for (int jj = 0; jj < 4; ++jj) { \
                if (xin16) xhq[jj] = __builtin_nontemporal_load((const u32x2*)(xh_ + 256 * jj)); \
                else xq[jj] = __builtin_nontemporal_load((const f32x4*)(xr_ + 256 * jj)); \
                if (MODE == 0) yq0[jj] = *(const u32x2*)(Y + (size_t)row_ * D + 4 * F.lane + 256 * jj); \
                else { yq0[jj] = *(const u32x2*)(Y + (size_t)row_ * 2 * D + 4 * F.lane + 256 * jj); yq1[jj] = *(const u32x2*)(Y + (size_t)row_ * 2 * D + D + 4 * F.lane + 256 * jj); } } } while (0)
        LN_LOAD(0);
        for (int r = 0; r < 32; ++r) {
            const int row = row0 + r;
            f32x4 v[4]; float s = 0.f;
            float w0 = 1.f, w1 = 0.f;
            if (MODE == 1) { const unsigned* rt = route + (size_t)row * 4; w0 = __builtin_bit_cast(float, rt[1]); w1 = __builtin_bit_cast(float, rt[2]); }
#pragma unroll
            for (int jj = 0; jj < 4; ++jj) {
                f32x4 x = xq[jj];
                if (xin16) x = __builtin_convertvector(__builtin_bit_cast(f16x4_t, xhq[jj]), f32x4);
                f32x4 y;
                if (MODE == 0) { const u32x2 yw = yq0[jj]; y = (f32x4){bflo(yw.x), bfhi(yw.x), bflo(yw.y), bfhi(yw.y)}; }
                else { const u32x2 ya = yq0[jj], yb = yq1[jj];
                    y = (f32x4){bflo(ya.x), bfhi(ya.x), bflo(ya.y), bfhi(ya.y)} * w0 + (f32x4){bflo(yb.x), bfhi(yb.x), bflo(yb.y), bfhi(yb.y)} * w1; }
                v[jj] = x * ALPHA + gt[jj] * y;
                s += (v[jj][0] + v[jj][1]) + (v[jj][2] + v[jj][3]);
            }
            if (r + 1 < 32) LN_LOAD(r + 1);
            const float mean = wave_sum(s) * (1.f / D); float s2 = 0.f;
#pragma unroll
            for (int jj = 0; jj < 4; ++jj) { v[jj] = v[jj] - mean; s2 += (v[jj][0] * v[jj][0] + v[jj][1] * v[jj][1]) + (v[jj][2] * v[jj][2] + v[jj][3] * v[jj][3]); }
            const float rstd = 1.0f / sqrtf(wave_sum(s2) * (1.f / D) + LN_EPS);
            float* orow = F.out + (size_t)row * D + 4 * F.lane;
            unsigned long long* h8 = (unsigned long long*)(HB + (size_t)row * D + 4 * F.lane);
            float lg[NE];
#pragma unroll
            for (int e = 0; e < NE; ++e) lg[e] = 0.f;
            f32x4 hv[4];
#pragma unroll
            for (int jj = 0; jj < 4; ++jj) {
                const f32x4 xn = v[jj] * rstd * g4[jj] + b4[jj];
                if (xout16) __builtin_nontemporal_store(__builtin_bit_cast(u32x2, __builtin_convertvector(xn, f16x4_t)), (u32x2*)(XH + (size_t)row * D + 4 * F.lane + 256 * jj));
                else __builtin_nontemporal_store(xn, (f32x4*)(orow + 256 * jj));
                if (next_mod) {
                    const f32x4 h = xn * (1.0f + nsc[jj]) + nsh[jj];
                    hv[jj] = h;
                    if (H8 == 0) h8[64 * jj] = (unsigned long long)pk2(h[0], h[1]) | ((unsigned long long)pk2(h[2], h[3]) << 32);
                    if (ROUTE) {
#pragma unroll
                        for (int i = 0; i < 4; ++i) { const LAS f32x4* wp = (const LAS f32x4*)(wr_l + (4 * F.lane + 256 * jj + i) * 8); const f32x4 wa = wp[0], wb = wp[1];
                            lg[0] += h[i] * wa[0]; lg[1] += h[i] * wa[1]; lg[2] += h[i] * wa[2]; lg[3] += h[i] * wa[3]; lg[4] += h[i] * wb[0]; lg[5] += h[i] * wb[1]; lg[6] += h[i] * wb[2]; lg[7] += h[i] * wb[3]; }
                    }
                }
            }
            if (H8 == 2 && next_mod) {
                float am = 0.f;
#pragma unroll
                for (int jj = 0; jj < 4; ++jj) am = fmaxf(fmaxf(am, fmaxf(fabsf(hv[jj][0]), fabsf(hv[jj][1]))), fmaxf(fabsf(hv[jj][2]), fabsf(hv[jj][3])));
                h_store_i8(hv, am, (signed char*)HB + (size_t)row * D + 4 * F.lane, (float*)(F.ws + WS_HSC) + row, F.lane);
            }
            if (H8 == 1 && next_mod) {
                unsigned* q8 = (unsigned*)((signed char*)HB + (size_t)row * D + 4 * F.lane);
#pragma unroll
                for (int jj = 0; jj < 4; ++jj) { int p = pk_fp8(hv[jj][0] * H2_SCALE, hv[jj][1] * H2_SCALE, 0, false);
                    p = pk_fp8(hv[jj][2] * H2_SCALE, hv[jj][3] * H2_SCALE, p, true); q8[64 * jj] = (unsigned)p; }
            }
            if (ROUTE) {
#pragma unroll
                for (int e = 0; e < NE; ++e) lg[e] = wave_sum(lg[e]);
                int e0 = 0; float v0 = lg[0];
#pragma unroll
                for (int e = 1; e < NE; ++e) if (lg[e] > v0) { v0 = lg[e]; e0 = e; }
                int e1 = -1; float v1 = -3.0e38f;
#pragma unroll
                for (int e = 0; e < NE; ++e) if (e != e0 && lg[e] > v1) { v1 = lg[e]; e1 = e; }
                const float ex = __expf(v1 - v0), inv = 1.0f / (1.0f + ex);
                if (F.lane == 0) {
                    unsigned* rt = route + (size_t)row * 4; rt[0] = (unsigned)e0 | ((unsigned)e1 << 8); rt[1] = __builtin_bit_cast(unsigned, inv); rt[2] = __builtin_bit_cast(unsigned, ex * inv); rt[3] = 0u;
                    const int p0 = atomicAdd((int*)&lcnt[e0], 1); llist[e0 * 512 + p0] = row * 2;
                    const int p1 = atomicAdd((int*)&lcnt[e1], 1); llist[e1 * 512 + p1] = row * 2 + 1;
                }
            }
        }
    }
#undef LN_LOAD
    if (ROUTE) {
        __syncthreads();
        if (F.tid < NE) lcnt[8 + F.tid] = (int)__hip_atomic_fetch_add((unsigned*)(F.ctl + CW_CNT + (jm * 8 + F.tid) * 64), (unsigned)lcnt[F.tid], RLX_AGENT);
        __syncthreads();
        int* glist = (int*)(F.ws + WS_LIST);
#pragma unroll 1
        for (int e = 0; e < NE; ++e) { const int n = lcnt[e], base = lcnt[8 + e]; for (int i = F.tid; i < n; i += NTHR) glist[(size_t)e * M + base + i] = llist[e * 512 + i]; }
    }
}

constexpr int P64 = 144;
constexpr int P128 = 272;
__device__ __forceinline__ void hgrn_m1(Frame& F) {
    PHASE_TID(F);
    LAS unsigned char* KT = F.lds; LAS unsigned char* VT = F.lds + 18432; LAS float* Tl = (LAS float*)(F.lds + 36864); LAS float* Dl = (LAS float*)(F.lds + 38912);
    const bf16* PROJ = (const bf16*)(F.ws + WS_PROJ);
    bf16* RS = (bf16*)(F.ws + WS_RS); float* RD = (float*)(F.ws + WS_RD);
    const int k = F.tid & 127, i = F.tid >> 7;
    const int r32 = F.lane & 31, hi = F.lane >> 5;
    unsigned short gr[16], vr[16];
#define M1_LOAD(un) do { const int bh_ = (un) >> 6, c_ = (un) & 63; const bf16* prow_ = PROJ + ((size_t)(bh_ >> 2) * SEQ + 64 * c_ + 16 * i) * NPROJ + 128 * (bh_ & 3) + k; \
        _Pragma("unroll") for (int j = 0; j < 16; ++j) { gr[j] = prow_[(size_t)j * NPROJ + C_HG]; vr[j] = prow_[(size_t)j * NPROJ + C_HV]; } } while (0)
    if (F.bx < 256) M1_LOAD(16 * F.bx);
    for (int rg = F.bx; rg < 256; rg += F.G) {
        const int kt = F.wave >> 1, vt0 = 2 * (F.wave & 1);
        f32x16 st[2];
#pragma unroll
        for (int x = 0; x < 2; ++x)
#pragma unroll
            for (int r = 0; r < 16; ++r) st[x][r] = 0.f;
        float dpre = 1.0f;
#pragma unroll 1
        for (int cc = 0; cc < 16; ++cc) {
            const int unit = 16 * rg + cc;
            float g[16];
#pragma unroll
            for (int j = 0; j < 16; ++j) g[j] = bf2f(gr[j]);
            float cs[16]; float run = 0.f;
#pragma unroll
            for (int j = 0; j < 16; ++j) { run += g[j]; cs[j] = run; }
            Tl[i * 128 + k] = run;
            __syncthreads();
            const float T0 = Tl[k], T1 = Tl[128 + k], T2 = Tl[256 + k], T3 = Tl[384 + k];
            const float after = (i == 0) ? (T1 + T2 + T3) : (i == 1) ? (T2 + T3) : (i == 2) ? T3 : 0.f;
            const float Gi = __expf(after);
            if (i == 0) { const float dc = __expf(T0 + T1 + T2 + T3); dpre *= dc; Dl[k] = dc; }
            unsigned kw[8], vw[8];
            float fj[16], e2a[16];
#pragma unroll
            for (int j = 0; j < 16; ++j) fj[j] = __expf(g[j]);
            { float p = Gi;
#pragma unroll
              for (int j = 15; j >= 0; --j) { e2a[j] = p; p *= fj[j]; } }
#pragma unroll
            for (int j = 0; j < 16; j += 2) {
                const float ka = (1.0f - fj[j]) * e2a[j], kb2 = (1.0f - fj[j + 1]) * e2a[j + 1];
                kw[j >> 1] = pk2(ka, kb2); vw[j >> 1] = (unsigned)vr[j] | ((unsigned)vr[j + 1] << 16);
            }
            *(LAS u32x4*)(KT + k * P64 + 32 * i) = (u32x4){kw[0], kw[1], kw[2], kw[3]}; *(LAS u32x4*)(KT + k * P64 + 32 * i + 16) = (u32x4){kw[4], kw[5], kw[6], kw[7]};
            *(LAS u32x4*)(VT + k * P64 + 32 * i) = (u32x4){vw[0], vw[1], vw[2], vw[3]}; *(LAS u32x4*)(VT + k * P64 + 32 * i + 16) = (u32x4){vw[4], vw[5], vw[6], vw[7]};
            { const int nu = (cc < 15) ? unit + 1 : 16 * (rg + F.G); if (nu < 4096) M1_LOAD(nu); }
            __syncthreads();
#pragma unroll
            for (int g4 = 0; g4 < 4; ++g4) { const f32x4 d4 = *(const LAS f32x4*)(Dl + 32 * kt + 8 * g4 + 4 * hi);
#pragma unroll
                for (int x = 0; x < 2; ++x)
#pragma unroll
                    for (int j = 0; j < 4; ++j) st[x][4 * g4 + j] *= d4[j]; }
#pragma unroll
            for (int s2 = 0; s2 < 4; ++s2) {
                const bf16x8 a = *(const LAS bf16x8*)(KT + (32 * kt + r32) * P64 + (8 * hi + 16 * s2) * 2);
#pragma unroll
                for (int x = 0; x < 2; ++x) { const bf16x8 bb = *(const LAS bf16x8*)(VT + (32 * (vt0 + x) + r32) * P64 + (8 * hi + 16 * s2) * 2);
                    st[x] = __builtin_amdgcn_mfma_f32_32x32x16_bf16(a, bb, st[x], 0, 0, 0); }
            }
            __syncthreads();
        }
#pragma unroll
        for (int x = 0; x < 2; ++x)
#pragma unroll
            for (int g4 = 0; g4 < 4; ++g4) { u32x2 w; w.x = cvt_pk_bf16(st[x][4 * g4], st[x][4 * g4 + 1]); w.y = cvt_pk_bf16(st[x][4 * g4 + 2], st[x][4 * g4 + 3]);
                *(u32x2*)(RS + (size_t)rg * 16384 + (size_t)(32 * (vt0 + x) + r32) * 128 + 32 * kt + 8 * g4 + 4 * hi) = w; }
        if (i == 0) RD[(size_t)rg * 128 + k] = dpre;
    }
}
#undef M1_LOAD
__device__ __forceinline__ void hgrn_m2(Frame& F) {
    PHASE_TID(F);
    bf16* RS = (bf16*)(F.ws + WS_RS); const float* RD = (const float*)(F.ws + WS_RD);
    for (int gid = F.bx * NTHR + F.tid; gid < 64 * 2048; gid += F.G * NTHR) {
        const int bh = gid >> 11, e0 = (gid & 2047) * 8, k0 = e0 & 127;
        float S[8];
        float z0 = 0.f; asm volatile("" : "+v"(z0));
#pragma unroll
        for (int j = 0; j < 8; ++j) S[j] = z0;
        bf16* p = RS + (size_t)bh * 4 * 16384 + e0; const float* dp = RD + (size_t)bh * 4 * 128 + k0;
#pragma unroll
        for (int c = 0; c < 4; ++c) {
            const u32x4 u = *(const u32x4*)(p + (size_t)c * 16384);
            const f32x4 d0 = *(const f32x4*)(dp + c * 128), d1 = *(const f32x4*)(dp + c * 128 + 4);
            u32x4 o; o.x = pk2(S[0], S[1]); o.y = pk2(S[2], S[3]); o.z = pk2(S[4], S[5]); o.w = pk2(S[6], S[7]);
            *(u32x4*)(p + (size_t)c * 16384) = o;
            S[0] = d0[0] * S[0] + bflo(u.x); S[1] = d0[1] * S[1] + bfhi(u.x); S[2] = d0[2] * S[2] + bflo(u.y); S[3] = d0[3] * S[3] + bfhi(u.y);
            S[4] = d1[0] * S[4] + bflo(u.z); S[5] = d1[1] * S[5] + bfhi(u.z); S[6] = d1[2] * S[6] + bflo(u.w); S[7] = d1[3] * S[7] + bfhi(u.w);
        }
    }
}
__device__ __forceinline__ void hgrn_m3(Frame& F) {
    PHASE_TID(F);
    LAS unsigned char* QT = F.lds; LAS unsigned char* QH = F.lds + 17408; LAS unsigned char* KH = F.lds + 60928; LAS unsigned char* VT = F.lds + 78336;
    LAS unsigned char* ST = F.lds + 96768; LAS float* Tl = (LAS float*)(F.lds + 131584); LAS float* SS = (LAS float*)(F.lds + 133632);
    LAS float* Dl = (LAS float*)(F.lds + 134144); LAS unsigned char* KT = F.lds + 134656;
    const bf16* PROJ = (const bf16*)(F.ws + WS_PROJ); bf16* HB = (bf16*)(F.ws + WS_HB);
    const bf16* RS = (const bf16*)(F.ws + WS_RS);
    const int r32 = F.lane & 31, hi5 = F.lane >> 5, kt = F.wave >> 1, vt0 = 2 * (F.wave & 1);
    const int k = F.tid & 127, i = F.tid >> 7;
    const int c16 = F.lane & 15, g = F.lane >> 4;
    const int wi = F.wave & 3, vh = F.wave >> 2;
    unsigned short qr[16], gr[16], vq[16];
#define M3_LOAD(un) do { const int bh_ = (un) >> 6, c_ = (un) & 63; const bf16* prow_ = PROJ + ((size_t)(bh_ >> 2) * SEQ + 64 * c_ + 16 * i) * NPROJ + 128 * (bh_ & 3) + k; \
        _Pragma("unroll") for (int j = 0; j < 16; ++j) { qr[j] = prow_[(size_t)j * NPROJ + C_HQ]; gr[j] = prow_[(size_t)j * NPROJ + C_HG]; vq[j] = prow_[(size_t)j * NPROJ + C_HV]; } } while (0)
    if (F.bx < 256) M3_LOAD(16 * F.bx);
    for (int rg = F.bx; rg < 256; rg += F.G) {
      f32x16 st[2];
#pragma unroll
      for (int x = 0; x < 2; ++x)
#pragma unroll
          for (int g4 = 0; g4 < 4; ++g4) { const u32x2 w = *(const u32x2*)(RS + (size_t)rg * 16384 + (size_t)(32 * (vt0 + x) + r32) * 128 + 32 * kt + 8 * g4 + 4 * hi5);
              st[x][4 * g4] = bflo(w.x); st[x][4 * g4 + 1] = bfhi(w.x); st[x][4 * g4 + 2] = bflo(w.y); st[x][4 * g4 + 3] = bfhi(w.y); }
#pragma unroll 1
      for (int cc = 0; cc < 16; ++cc) {
        const int unit = 16 * rg + cc;
        const int bh = unit >> 6, c = unit & 63, b = bh >> 2, h = bh & 3;
        const size_t t0 = (size_t)b * SEQ + 64 * c;
        float q[16], gg[16]; unsigned short vr[16];
#pragma unroll
        for (int j = 0; j < 16; ++j) { q[j] = bf2f(qr[j]); gg[j] = bf2f(gr[j]); vr[j] = vq[j]; }
        float cs[16]; float run = 0.f;
#pragma unroll
        for (int j = 0; j < 16; ++j) { run += gg[j]; cs[j] = run; }
        Tl[i * 128 + k] = run;
        __syncthreads();
        const float T0 = Tl[k], T1 = Tl[128 + k], T2 = Tl[256 + k], T3 = Tl[384 + k];
        const float Bi = (i == 0) ? 0.f : (i == 1) ? T0 : (i == 2) ? (T0 + T1) : (T0 + T1 + T2);
        const float Gi = __expf((i == 0) ? (T1 + T2 + T3) : (i == 1) ? (T2 + T3) : (i == 2) ? T3 : 0.f);
        if (i == 0) Dl[k] = __expf(T0 + T1 + T2 + T3);
        const float eB = __expf(Bi);
        float Fq[4];
        Fq[0] = (i == 0) ? __expf(fminf(-run, 80.f)) : (i == 1) ? 1.0f : (i == 2) ? __expf(T1) : __expf(T1 + T2);
        Fq[1] = (i == 1) ? __expf(fminf(-run, 80.f)) : (i == 2) ? 1.0f : __expf(T2);
        Fq[2] = (i == 2) ? __expf(fminf(-run, 80.f)) : 1.0f;
        Fq[3] = __expf(fminf(-run, 80.f));
        const int blk0 = (i * (i + 1)) >> 1;
        unsigned vw[8], kw[8];
        float fj[16], e1a[16], e2a[16];
#pragma unroll
        for (int j = 0; j < 16; ++j) fj[j] = __expf(gg[j]);
        { float p = 1.0f;
#pragma unroll
          for (int j = 0; j < 16; ++j) { p *= fj[j]; e1a[j] = p; }
          p = 1.0f;
#pragma unroll
          for (int j = 15; j >= 0; --j) { e2a[j] = p; p *= fj[j]; } }
#pragma unroll
        for (int j = 0; j < 16; ++j) {
            const float e1 = e1a[j], e2 = e2a[j], kk = 1.0f - fj[j];
            const float qe = q[j] * e1;
            *(LAS unsigned short*)(QT + (16 * i + j) * P128 + k * 2) = (unsigned short)f2bf(qe * eB);
            *(LAS unsigned short*)(KH + (16 * i + j) * P128 + k * 2) = (unsigned short)f2bf(kk * e2);
#pragma unroll
            for (int jj = 0; jj < 4; ++jj) if (jj <= i) *(LAS unsigned short*)(QH + (blk0 + jj) * (16 * P128) + j * P128 + k * 2) = (unsigned short)f2bf(qe * Fq[jj]);
            if (j & 1) { vw[j >> 1] = (unsigned)vr[j - 1] | ((unsigned)vr[j] << 16); kw[j >> 1] = pk2((1.0f - fj[j - 1]) * e2a[j - 1] * Gi, kk * e2 * Gi); }
        }
        *(LAS u32x4*)(KT + k * P64 + 32 * i) = (u32x4){kw[0], kw[1], kw[2], kw[3]}; *(LAS u32x4*)(KT + k * P64 + 32 * i + 16) = (u32x4){kw[4], kw[5], kw[6], kw[7]};
        *(LAS u32x4*)(VT + k * P64 + 32 * i) = (u32x4){vw[0], vw[1], vw[2], vw[3]}; *(LAS u32x4*)(VT + k * P64 + 32 * i + 16) = (u32x4){vw[4], vw[5], vw[6], vw[7]};
#pragma unroll
        for (int x = 0; x < 2; ++x)
#pragma unroll
            for (int g4 = 0; g4 < 4; ++g4) { u32x2 w; w.x = cvt_pk_bf16(st[x][4 * g4], st[x][4 * g4 + 1]); w.y = cvt_pk_bf16(st[x][4 * g4 + 2], st[x][4 * g4 + 3]);
                *(LAS u32x2*)(ST + (32 * (vt0 + x) + r32) * P128 + (32 * kt + 8 * g4 + 4 * hi5) * 2) = w; }
        { const int nu = (cc < 15) ? unit + 1 : 16 * (rg + F.G); if (nu < 4096) M3_LOAD(nu); }
        __syncthreads();
#pragma unroll
        for (int g4 = 0; g4 < 4; ++g4) { const f32x4 d4 = *(const LAS f32x4*)(Dl + 32 * kt + 8 * g4 + 4 * hi5);
#pragma unroll
            for (int x = 0; x < 2; ++x)
#pragma unroll
                for (int j = 0; j < 4; ++j) st[x][4 * g4 + j] *= d4[j]; }
#pragma unroll
        for (int s2 = 0; s2 < 4; ++s2) {
            const bf16x8 a = *(const LAS bf16x8*)(KT + (32 * kt + r32) * P64 + (8 * hi5 + 16 * s2) * 2);
#pragma unroll
            for (int x = 0; x < 2; ++x) { const bf16x8 bb = *(const LAS bf16x8*)(VT + (32 * (vt0 + x) + r32) * P64 + (8 * hi5 + 16 * s2) * 2);
                st[x] = __builtin_amdgcn_mfma_f32_32x32x16_bf16(a, bb, st[x], 0, 0, 0); }
        }
        unsigned short gv[4][4];
#pragma unroll
        for (int vt = 0; vt < 4; ++vt)
#pragma unroll
            for (int r = 0; r < 4; ++r) gv[vt][r] = PROJ[(t0 + 16 * wi + 4 * g + r) * NPROJ + C_HGATE + 128 * h + 64 * vh + 16 * vt + c16];
        unsigned pk[4][2];
#pragma unroll
        for (int jj = 0; jj < 4; ++jj) { pk[jj][0] = 0u; pk[jj][1] = 0u; }
#pragma unroll
        for (int jj = 0; jj < 4; ++jj) {
            if (jj <= wi) {
                f32x4 sc = (f32x4){0.f, 0.f, 0.f, 0.f};
                const int blk = ((wi * (wi + 1)) >> 1) + jj;
#pragma unroll
                for (int ks = 0; ks < 4; ++ks) {
                    const bf16x8 a = *(const LAS bf16x8*)(KH + (16 * jj + c16) * P128 + (8 * g + 32 * ks) * 2);
                    const bf16x8 bq = *(const LAS bf16x8*)(QH + blk * (16 * P128) + c16 * P128 + (8 * g + 32 * ks) * 2);
                    sc = __builtin_amdgcn_mfma_f32_16x16x32_bf16(a, bq, sc, 0, 0, 0);
                }
                if (jj == wi) {
#pragma unroll
                    for (int r = 0; r < 4; ++r) if (4 * g + r > c16) sc[r] = 0.f;
                }
                pk[jj][0] = cvt_pk_bf16(sc[0], sc[1]); pk[jj][1] = cvt_pk_bf16(sc[2], sc[3]);
            }
        }
        f32x4 o[4];
#pragma unroll
        for (int vt = 0; vt < 4; ++vt) {
            o[vt] = (f32x4){0.f, 0.f, 0.f, 0.f};
            const int v = 64 * vh + 16 * vt + c16;
            { const u32x4 aw = (u32x4){pk[0][0], pk[0][1], pk[1][0], pk[1][1]};
              const u32x2 b0 = *(const LAS u32x2*)(VT + v * P64 + (0 + 4 * g) * 2), b1 = *(const LAS u32x2*)(VT + v * P64 + (16 + 4 * g) * 2);
              const u32x4 bw = (u32x4){b0.x, b0.y, b1.x, b1.y};
              o[vt] = __builtin_amdgcn_mfma_f32_16x16x32_bf16(__builtin_bit_cast(bf16x8, aw), __builtin_bit_cast(bf16x8, bw), o[vt], 0, 0, 0); }
            if (wi >= 2) {
              const u32x4 aw = (u32x4){pk[2][0], pk[2][1], pk[3][0], pk[3][1]};
              const u32x2 b0 = *(const LAS u32x2*)(VT + v * P64 + (32 + 4 * g) * 2), b1 = *(const LAS u32x2*)(VT + v * P64 + (48 + 4 * g) * 2);
              const u32x4 bw = (u32x4){b0.x, b0.y, b1.x, b1.y};
              o[vt] = __builtin_amdgcn_mfma_f32_16x16x32_bf16(__builtin_bit_cast(bf16x8, aw), __builtin_bit_cast(bf16x8, bw), o[vt], 0, 0, 0); }
#pragma unroll
            for (int ks = 0; ks < 4; ++ks) {
                const bf16x8 a = *(const LAS bf16x8*)(QT + (16 * wi + c16) * P128 + (8 * g + 32 * ks) * 2);
                const bf16x8 bs = *(const LAS bf16x8*)(ST + v * P128 + (8 * g + 32 * ks) * 2);
                o[vt] = __builtin_amdgcn_mfma_f32_16x16x32_bf16(a, bs, o[vt], 0, 0, 0);
            }
        }
        float ssq[4];
#pragma unroll
        for (int r = 0; r < 4; ++r) { float s = 0.f;
#pragma unroll
            for (int vt = 0; vt < 4; ++vt) s += o[vt][r] * o[vt][r];
            s += __shfl_xor(s, 1); s += __shfl_xor(s, 2); s += __shfl_xor(s, 4); s += __shfl_xor(s, 8); ssq[r] = s; }
        if (c16 == 0) {
#pragma unroll
            for (int r = 0; r < 4; ++r) SS[vh * 64 + 16 * wi + 4 * g + r] = ssq[r];
        }
        __syncthreads();
#pragma unroll
        for (int r = 0; r < 4; ++r) {
            const int t = 16 * wi + 4 * g + r;
            const float tot = SS[t] + SS[64 + t];
            const float rstd = 1.0f / sqrtf(tot * (1.0f / 128.0f) + RMS_EPS);
#pragma unroll
            for (int vt = 0; vt < 4; ++vt) HB[(t0 + t) * D + 128 * h + 64 * vh + 16 * vt + c16] = (unsigned short)f2bf(o[vt][r] * rstd * bf2f(gv[vt][r]));
        }
        __syncthreads();
      }
    }
}

#undef M3_LOAD
__device__ __forceinline__ void sb_attn(Frame& F) {
    PHASE_TID(F);
    const bf16* PROJ = (const bf16*)(F.ws + WS_PROJ); bf16* HB = (bf16*)(F.ws + WS_HB);
    LAS unsigned char* Vb = F.lds + 40960 + F.wave * 4608;
    LAS unsigned char* Qs = F.lds + 77824 + F.wave * 8192;
    const int lane = F.lane, r32 = F.lane & 31, hi = F.lane >> 5;
    const int gw = F.bx * NWAVES + F.wave, NGW = F.G * NWAVES;
    for (int u = gw; u < NB * 8 * 64; u += NGW) {
        const int b = u >> 9, h = (u >> 6) & 7, qL = 2 * (u & 63), qU = qL + 1;
        const size_t tok0 = (size_t)b * SEQ;
        { const bf16* Qp = PROJ + (tok0 + 32 * qL + r32) * NPROJ + C_SQ + 64 * h + 8 * hi;
          bf16x8 qt[8];
#pragma unroll
          for (int ds = 0; ds < 4; ++ds) { qt[ds] = *(const bf16x8*)(Qp + 16 * ds); qt[4 + ds] = *(const bf16x8*)(Qp + (size_t)32 * NPROJ + 16 * ds); }
#pragma unroll
          for (int i = 0; i < 8; ++i) *(LAS bf16x8*)(Qs + (i * 64 + lane) * 16) = qt[i]; }
        f32x16 oL[2], oU[2];
#pragma unroll
        for (int x = 0; x < 2; ++x)
#pragma unroll
            for (int r = 0; r < 16; ++r) { oL[x][r] = 0.f; oU[x][r] = 0.f; }
        float CL = 1.0f, CU = 1.0f;
        bool doneL = false, doneU = false;
        bf16x8 kf[4]; u32x4 vreg[4];
        { const bf16* Kp = PROJ + (tok0 + 32 * qU + r32) * NPROJ + C_SK + 64 * h + 8 * hi;
#pragma unroll
          for (int ds = 0; ds < 4; ++ds) kf[ds] = *(const bf16x8*)(Kp + 16 * ds);
#pragma unroll
          for (int n = 0; n < 4; ++n) { const int idx = lane + 64 * n; vreg[n] = *(const u32x4*)(PROJ + (tok0 + 32 * qU + (idx >> 3)) * NPROJ + C_SV + 64 * h + 8 * (idx & 7)); } }
        auto scores = [&](int up) __attribute__((always_inline)) -> f32x16 {
            f32x16 s;
#pragma unroll
            for (int r = 0; r < 16; ++r) s[r] = 0.f;
#pragma unroll
            for (int ds = 0; ds < 4; ++ds) { const bf16x8 qf = *(const LAS bf16x8*)(Qs + ((4 * up + ds) * 64 + lane) * 16); s = __builtin_amdgcn_mfma_f32_32x32x16_bf16(kf[ds], qf, s, 0, 0, 0); }
            return s;
        };
        auto weigh = [&](f32x16& s, f32x16 (&o)[2], float& C, bool diag) __attribute__((always_inline)) {
            if (diag) {
#pragma unroll
                for (int r = 0; r < 16; ++r) { const int key = (r & 3) + 8 * (r >> 2) + 4 * hi; s[r] = (key < r32) ? s[r] : -1e30f; }
            }
            float rm[16], bt[16];
#pragma unroll
            for (int r = 0; r < 16; ++r) {
                const float q1 = fast_rcp(1.0f + __builtin_amdgcn_exp2f(s[r]));
                rm[r] = q1;
                bt[r] = 1.0f - q1;
            }
            float Gs[4], Gp[4];
#pragma unroll
            for (int g4 = 0; g4 < 4; ++g4) { Gs[g4] = (rm[4 * g4] * rm[4 * g4 + 1]) * (rm[4 * g4 + 2] * rm[4 * g4 + 3]);
                const unsigned own = __builtin_bit_cast(unsigned, Gs[g4]);
                const u32x2 sw = __builtin_amdgcn_permlane32_swap(own, own, false, false);
                const unsigned r0 = sw.x, r1 = sw.y;
                Gp[g4] = __builtin_bit_cast(float, (r0 == own) ? r1 : r0); }
            float run = C;
            float a[16];
#pragma unroll
            for (int g4 = 3; g4 >= 0; --g4) {
                float sfx = run * (hi == 0 ? Gp[g4] : 1.0f);
                a[4 * g4 + 3] = bt[4 * g4 + 3] * sfx; sfx *= rm[4 * g4 + 3];
                a[4 * g4 + 2] = bt[4 * g4 + 2] * sfx; sfx *= rm[4 * g4 + 2];
                a[4 * g4 + 1] = bt[4 * g4 + 1] * sfx; sfx *= rm[4 * g4 + 1];
                a[4 * g4 + 0] = bt[4 * g4 + 0] * sfx;
                run *= Gs[g4] * Gp[g4];
            }
            C = run;
#pragma unroll
            for (int s2 = 0; s2 < 2; ++s2) {
                u32x4 pw; pw.x = cvt_pk_bf16(a[8 * s2 + 0], a[8 * s2 + 1]); pw.y = cvt_pk_bf16(a[8 * s2 + 2], a[8 * s2 + 3]); pw.z = cvt_pk_bf16(a[8 * s2 + 4], a[8 * s2 + 5]); pw.w = cvt_pk_bf16(a[8 * s2 + 6], a[8 * s2 + 7]);
                const bf16x8 pf = __builtin_bit_cast(bf16x8, pw);
#pragma unroll
                for (int dt = 0; dt < 2; ++dt) {
                    const int dcol = 32 * dt + 16 * ((lane >> 4) & 1) + 4 * (lane & 3);
                    const int krow = 16 * s2 + 4 * hi + ((lane & 15) >> 2);
                    const s16x4 t0v = __builtin_bit_cast(s16x4, __builtin_amdgcn_ds_read_tr16_b64_v4i16((LAS s16x4*)(Vb + krow * P64 + dcol * 2)));
                    const s16x4 t1v = __builtin_bit_cast(s16x4, __builtin_amdgcn_ds_read_tr16_b64_v4i16((LAS s16x4*)(Vb + (krow + 8) * P64 + dcol * 2)));
                    const bf16x8 vf = (bf16x8){t0v[0], t0v[1], t0v[2], t0v[3], t1v[0], t1v[1], t1v[2], t1v[3]};
                    o[dt] = __builtin_amdgcn_mfma_f32_32x32x16_bf16(vf, pf, o[dt], 0, 0, 0);
                }
            }
        };
        for (int kb = qU; kb >= 0; --kb) {
            const bool actU = !doneU, actL = (kb <= qL) && !doneL;
#pragma unroll
            for (int n = 0; n < 4; ++n) { const int idx = lane + 64 * n; *(LAS u32x4*)(Vb + (idx >> 3) * P64 + (idx & 7) * 16) = vreg[n]; }
            f32x16 sU, sL;
            if (actU) sU = scores(1);
            if (actL) sL = scores(0);
            if (kb > 0) {
                const bf16* Kp = PROJ + (tok0 + 32 * (kb - 1) + r32) * NPROJ + C_SK + 64 * h + 8 * hi;
#pragma unroll
                for (int ds = 0; ds < 4; ++ds) kf[ds] = *(const bf16x8*)(Kp + 16 * ds);
#pragma unroll
                for (int n = 0; n < 4; ++n) { const int idx = lane + 64 * n; vreg[n] = *(const u32x4*)(PROJ + (tok0 + 32 * (kb - 1) + (idx >> 3)) * NPROJ + C_SV + 64 * h + 8 * (idx & 7)); }
            }
            if (actU) { weigh(sU, oU, CU, kb == qU); doneU = __all(CU < 0x1p-120f); }
            if (actL) { weigh(sL, oL, CL, kb == qL); doneL = __all(CL < 0x1p-120f); }
            if (doneU && doneL) break;
        }
        bf16* orow = HB + (tok0 + 32 * qL + r32) * D + 512 + 64 * h + (hi ? 8 : 0);
        auto store_o = [&](const f32x16 (&o)[2], bf16* rowp) __attribute__((always_inline)) {
#pragma unroll
            for (int dt = 0; dt < 2; ++dt)
#pragma unroll
                for (int g4 = 0; g4 < 4; g4 += 2) {
                    unsigned ax = cvt_pk_bf16(o[dt][4 * g4], o[dt][4 * g4 + 1]), ay = cvt_pk_bf16(o[dt][4 * g4 + 2], o[dt][4 * g4 + 3]);
                    unsigned bx = cvt_pk_bf16(o[dt][4 * g4 + 4], o[dt][4 * g4 + 5]), by = cvt_pk_bf16(o[dt][4 * g4 + 6], o[dt][4 * g4 + 7]);
                    const u32x2 rx = __builtin_amdgcn_permlane32_swap(ax, bx, false, false); ax = rx.x; bx = rx.y;
                    const u32x2 ry = __builtin_amdgcn_permlane32_swap(ay, by, false, false); ay = ry.x; by = ry.y;
                    *(u32x4*)(rowp + 32 * dt + 8 * g4) = (u32x4){ax, ay, bx, by}; }
        };
        store_o(oL, orow); store_o(oU, orow + (size_t)32 * D);
    }
}

constexpr int PH_PER_LAYER = 13, N_PHASES = 2 + DEPTH * PH_PER_LAYER;
__global__ void __launch_bounds__(NTHR, 2) fwd_kernel(Args args) {
    extern __shared__ __attribute__((aligned(16))) unsigned char lds_raw[];
    Frame F;
    F.lds = (LAS unsigned char*)lds_raw;
    F.tid = threadIdx.x; F.lane = F.tid & 63; F.wave = __builtin_amdgcn_readfirstlane(F.tid >> 6);
    F.G = gridDim.x; F.bx = blockIdx.x;
    F.ws = args.ws; F.ws0 = args.ws; F.ctl = (gu32*)(args.ws + WS_CTL); F.out = args.out;
    volatile LAS unsigned* MISC = (volatile LAS unsigned*)(F.lds + MISC_OFF);
    if (F.tid < 64) MISC[F.tid] = 0u;
    __syncthreads();
    XcdBarrier bar; bar.bar = (unsigned*)(F.ctl + CW_BAR); bar.x = 0; bar.st = nullptr;
    if (!MK_PER_PHASE_LAUNCH) bar = xcd_barrier_post((unsigned*)(F.ctl + CW_BAR), MISC + 8);
    const int lo = args.ph_lo, hi = args.ph_hi;
#define IN(k) (lo <= (k) && (k) < hi)
#define SEAM(k) do { if (IN(k) && IN((k) + 1)) xcd_barrier(bar); } while (0)
    const float* modp = (const float*)(F.ws + WS_MOD);
    const float* lbp = (const float*)(F.ws + WS_LB);
    static_assert((DEPTH - 1) & 1, "the last layer must be a MoE layer: its LayerNorm overwrites each row's pair outputs in d_out with the row's f32 result (same 4 KiB)");
    bf16* HB = (bf16*)(F.ws + WS_HB); bf16* PROJ = (bf16*)(F.ws + WS_PROJ); bf16* YP = (bf16*)F.out;

    if (IN(0)) { pre_phase(F, args); win_absmax_all(F, args); conv_layer(F, args, 0); }
    SEAM(0);
    if (IN(1)) { h0_phase(F, args); conv_win(F, args, 0); }
    SEAM(1);

#pragma unroll 1
    for (int layer = 0; layer < DEPTH; ++layer) {
        const int pb = 2 + layer * PH_PER_LAYER;
        const int moe = layer & 1, jm = layer >> 1;
        if (IN(pb + 0)) {
            gm::PlainPolicy P; P.o.init(M / 256, NPROJ / 256, F.G, F.bx); P.Bt = (const bf16*)(F.ws + WS_WIN);
            gm::EpiInproj8 E{PROJ, lbp + layer * 512, args.in[7] + layer * 512, (const float*)(F.ws + WS_HSC), (const float*)(F.ctl + CW_WMAX + layer * NPROJ)};
            gm::gemm_phase<false, gm::EpiInproj8, gm::PlainPolicy, 1>(F.lds, HB, D / 2, P, E);
        }
        SEAM(pb + 0);
        if (IN(pb + 1)) { hgrn_m1(F); sb_attn(F); }
        SEAM(pb + 1);
        if (IN(pb + 2)) hgrn_m2(F);
        SEAM(pb + 2);
        if (IN(pb + 3)) hgrn_m3(F);
        SEAM(pb + 3);
        if (IN(pb + 4)) {
            gm::PlainPolicy P; P.o.init(M / 256, D / 256, F.G, F.bx); P.Bt = (const bf16*)(F.ws + WS_WOUT);
            gm::EpiPlain E{PROJ, D};
            gm::gemm_phase<false, gm::EpiPlain, gm::PlainPolicy>(F.lds, HB, D, P, E);
        }
        SEAM(pb + 4);
        if (IN(pb + 5)) {
            const float* xsrc = args.in[0]; const bool xin16 = layer != 0;
            const float* gm_ = modp + (size_t)(layer * 2 + 0) * NB * 3072; const float* nm = modp + (size_t)(layer * 2 + 1) * NB * 3072;
            if (moe) ln_phase<0, true, 1>(F, xsrc, xin16, true, PROJ, gm_, args.in[15] + (size_t)(layer * 2 + 0) * D, args.in[16] + (size_t)(layer * 2 + 0) * D, nm, args.in[11] + (size_t)jm * D * NE, jm);
            else ln_phase<0, false, 1>(F, xsrc, xin16, true, PROJ, gm_, args.in[15] + (size_t)(layer * 2 + 0) * D, args.in[16] + (size_t)(layer * 2 + 0) * D, nm, nullptr, 0);
        }
        SEAM(pb + 5);
        const int npass = 1;
#pragma unroll 1
        for (int pass = 0; pass < npass; ++pass) {
            gm::FfnPolicy P;
            P.moe = moe; P.list = (const int*)(F.ws + WS_LIST); P.tile0 = pass * 256; P.tab = (LAS const int*)(F.lds + gm::TILE_TAB_OFF);
            int ntiles = 256;
            if (moe) {
                int tot = 0;
#pragma unroll
                for (int e = 0; e < NE; ++e) { const int c = (int)__hip_atomic_load((unsigned*)(F.ctl + CW_CNT + (jm * 8 + e) * 64), RLX_AGENT); tot += (c + 255) >> 8; }
                ntiles = __builtin_amdgcn_readfirstlane(tot);
                __syncthreads();
                for (int T = opaque_tid(); T < ntiles; T += NTHR) {
                    int acc_t = 0, me = 0, mpe = 0, mc = 0;
#pragma unroll
                    for (int e = 0; e < NE; ++e) { const int c = (int)__hip_atomic_load((unsigned*)(F.ctl + CW_CNT + (jm * 8 + e) * 64), RLX_AGENT);
                        if (acc_t <= T) { me = e; mpe = acc_t; mc = c; } acc_t += (c + 255) >> 8; }
                    const int aux = (T - mpe) * 256; const int left = mc - aux; const int cnt = left < 256 ? left : 256;
                    ((LAS int*)(F.lds + gm::TILE_TAB_OFF))[2 * T] = me | (cnt << 4); ((LAS int*)(F.lds + gm::TILE_TAB_OFF))[2 * T + 1] = aux;
                }
                __syncthreads();
            }
            const int nM = ntiles;
            const int ff = moe ? DFFE : DFF;
            if (IN(pb + 6 + 2 * pass)) {
                P.o.init(nM, ff / 128, F.G, F.bx); P.W = (const bf16*)(F.ws + WS_WGU); P.wstride = (size_t)DFFE * D; P.gatherA = 1;
                gm::EpiGU8 E{(unsigned char*)PROJ, ff};
                gm::gemm_phase<true, gm::EpiGU8, gm::FfnPolicy, 2>(F.lds, HB, D / 2, P, E);
            }
            SEAM(pb + 6 + 2 * pass);
            if (IN(pb + 7 + 2 * pass)) {
                P.o.init(nM, D / 256, F.G, F.bx); P.W = (const bf16*)(F.ws + WS_WDN); P.wstride = (size_t)D * DFFE / 2; P.gatherA = 0;
                gm::EpiDown E{YP, (const int*)(F.ws + WS_LIST), moe, 1.0f / (HID_SCALE * WDN_SCALE)};
                gm::gemm_phase<false, gm::EpiDown, gm::FfnPolicy, 2>(F.lds, PROJ, ff / 2, P, E);
            }
            if (pass + 1 < npass) SEAM(pb + 7 + 2 * pass);
        }
        if (IN(pb + 6 + 2 * npass - 1) && IN(pb + 12)) xcd_barrier(bar);
        if (IN(pb + 12)) {
            const float* gm_ = modp + (size_t)(layer * 2 + 1) * NB * 3072;
            const float* nm = (layer + 1 < DEPTH) ? modp + (size_t)((layer + 1) * 2 + 0) * NB * 3072 : nullptr;
            if (moe) ln_phase<1, false, 2>(F, args.in[0], true, layer + 1 < DEPTH, YP, gm_, args.in[15] + (size_t)(layer * 2 + 1) * D, args.in[16] + (size_t)(layer * 2 + 1) * D, nm, nullptr, 0);
            else ln_phase<0, false, 2>(F, args.in[0], true, layer + 1 < DEPTH, YP, gm_, args.in[15] + (size_t)(layer * 2 + 1) * D, args.in[16] + (size_t)(layer * 2 + 1) * D, nm, nullptr, 0);
            if (layer + 1 < DEPTH) { __syncthreads(); conv_layer(F, args, layer + 1); conv_win(F, args, layer + 1); }
        }
        if (layer + 1 < DEPTH) SEAM(pb + 12);
    }
#undef IN
#undef SEAM
}

extern "C" void kernel_launch(void* const* d_in, const int* in_sizes, int n_in, void* d_out, int out_size, void* d_ws, size_t ws_size, hipStream_t stream) {
    static int grid = 0;
    if (grid == 0) {
        if (n_in != 17 || in_sizes[0] != M * D || out_size != M * D || ws_size < WS_END) { fprintf(stderr, "kernel_launch: unexpected shapes / workspace (%d inputs, ws %zu, need %zu); nothing launched\n", n_in, ws_size, (size_t)WS_END); grid = -1; return; }
        int dev = 0, cus = 0, per_cu = 0;
        if (hipGetDevice(&dev) != hipSuccess || hipDeviceGetAttribute(&cus, hipDeviceAttributeMultiprocessorCount, dev) != hipSuccess) { grid = -1; return; }
        if (hipFuncSetAttribute((const void*)fwd_kernel, hipFuncAttributeMaxDynamicSharedMemorySize, LDS_BYTES) != hipSuccess) { fprintf(stderr, "kernel_launch: hipFuncSetAttribute failed\n"); grid = -1; return; }
        if (hipOccupancyMaxActiveBlocksPerMultiprocessor(&per_cu, (const void*)fwd_kernel, NTHR, LDS_BYTES) != hipSuccess || per_cu < 1) fprintf(stderr, "kernel_launch: occupancy query reports %d\n", per_cu);
        (void)hipGetLastError();
        grid = cus;
    }
    if (grid < 0) return;
    if (hipMemsetAsync((char*)d_ws + WS_CTL, 0, CTL_ZERO_BYTES, stream) != hipSuccess) return;
    Args a{};
    for (int i = 0; i < 17; ++i) a.in[i] = (const float*)d_in[i];
    a.out = (float*)d_out; a.ws = (unsigned char*)d_ws;
#if MK_PER_PHASE_LAUNCH
    for (int p = 0; p < N_PHASES; ++p) {
        const int slot = (p - 2) % PH_PER_LAYER, layer = (p - 2) / PH_PER_LAYER;
        if (p >= 2 && (layer & 1) == 0 && slot >= 8 && slot <= 11) continue;
        a.ph_lo = p; a.ph_hi = p + 1;
        hipLaunchKernelGGL(fwd_kernel, dim3(grid), dim3(NTHR), LDS_BYTES, stream, a);
    }
#else
    a.ph_lo = 0; a.ph_hi = N_PHASES;
    hipLaunchKernelGGL(fwd_kernel, dim3(grid), dim3(NTHR), LDS_BYTES, stream, a);
#endif
}
```

```cpp
#include <hip/hip_runtime.h>
#include <cstdio>
#include <cstdint>

#ifndef MK_PER_PHASE_LAUNCH
#define MK_PER_PHASE_LAUNCH 0
#endif

#define GAS __attribute__((address_space(1)))
#define LAS __attribute__((address_space(3)))
typedef unsigned short bf16;
typedef short bf16x8 __attribute__((ext_vector_type(8)));
typedef short s16x4 __attribute__((ext_vector_type(4)));
typedef float f32x4 __attribute__((ext_vector_type(4)));
typedef float f32x16 __attribute__((ext_vector_type(16)));
typedef unsigned u32x4 __attribute__((ext_vector_type(4)));
typedef unsigned u32x2 __attribute__((ext_vector_type(2)));
typedef int i32x4 __attribute__((ext_vector_type(4)));
typedef int i32x8 __attribute__((ext_vector_type(8)));
typedef GAS unsigned gu32;

constexpr int NB = 16, SEQ = 4096, D = 1024, M = NB * SEQ, DEPTH = 4;
constexpr int NPROJ = 3584, DFF = 2816, DFFE = 3584, NE = 8;
constexpr int C_HQ = 0, C_HG = 512, C_HV = 1024, C_HGATE = 1536, C_SQ = 2048, C_SK = 2560, C_SV = 3072;
constexpr float ALPHA = 1.681792830507429f;
constexpr float LN_EPS = 1e-5f, RMS_EPS = 1e-6f;
constexpr float LOG2E = 1.4426950408889634f;
constexpr float HID_SCALE = 16.0f, WDN_SCALE = 256.0f, H2_SCALE = 8.0f, WGU_SCALE = 128.0f;
constexpr int NWAVES = 8, NTHR = 512;

constexpr size_t MiB = 1u << 20;
constexpr size_t WS_CTL = 0, CTL_ZERO_BYTES = 1 * MiB;
constexpr size_t WS_MOD = 1 * MiB;
constexpr size_t WS_LB = WS_MOD + 1536 * 1024;
constexpr size_t WS_HSC = WS_LB + 65536;
constexpr size_t WS_ROUTE = 3 * MiB;
constexpr size_t WS_LIST = 4 * MiB;
constexpr size_t WS_HD = 6 * MiB;
constexpr size_t WS_WIN = 8 * MiB;
constexpr size_t WS_WOUT = 15 * MiB;
constexpr size_t WS_WGU = 17 * MiB;
constexpr size_t WS_WDN = 129 * MiB;
constexpr size_t WS_RS = WS_WGU + 56 * MiB;
constexpr size_t WS_RD = WS_RS + 8 * MiB;
constexpr size_t WS_HB = 185 * MiB;
constexpr size_t WS_PROJ = 313 * MiB;
constexpr size_t WS_YP = 768 * MiB;
constexpr size_t WS_XH = 896 * MiB;
constexpr size_t WS_END = 1024 * MiB;
constexpr int CW_TMO = 0;
constexpr int CW_BAR = 4096;
constexpr int CW_WMAX = 131072;
constexpr int CW_CNT = 16384;

constexpr int LDS_BYTES = 163840;
constexpr int MISC_OFF = LDS_BYTES - 256;

#define RLX_AGENT __ATOMIC_RELAXED, __HIP_MEMORY_SCOPE_AGENT
#define LDS_WAIT() asm volatile("s_waitcnt lgkmcnt(0)" ::: "memory")
#define VM_WAIT() asm volatile("s_waitcnt vmcnt(0)" ::: "memory")

__device__ __forceinline__ float bf2f(unsigned short b) { return __builtin_bit_cast(float, (unsigned)b << 16); }
__device__ __forceinline__ float bflo(unsigned w) { return __builtin_bit_cast(float, w << 16); }
__device__ __forceinline__ float bfhi(unsigned w) { return __builtin_bit_cast(float, w & 0xffff0000u); }
typedef _Float16 f16x4_t __attribute__((ext_vector_type(4)));
typedef float f32x2_t __attribute__((ext_vector_type(2))); typedef __bf16 bf16x2_t __attribute__((ext_vector_type(2)));
__device__ __forceinline__ unsigned cvt_pk_bf16(float lo, float hi) { f32x2_t v = {lo, hi}; bf16x2_t b = __builtin_convertvector(v, bf16x2_t); return __builtin_bit_cast(unsigned, b); }
__device__ __forceinline__ unsigned pk2(float lo, float hi) { return cvt_pk_bf16(lo, hi); }
__device__ __forceinline__ unsigned f2bf(float f) { return cvt_pk_bf16(f, 0.f) & 0xffffu; }
__device__ __forceinline__ int pk_fp8(float a, float b, int old, bool hi) {
    a = __builtin_amdgcn_fmed3f(a, -448.0f, 448.0f); b = __builtin_amdgcn_fmed3f(b, -448.0f, 448.0f);
    return hi ? __builtin_amdgcn_cvt_pk_fp8_f32(a, b, old, true) : __builtin_amdgcn_cvt_pk_fp8_f32(a, b, old, false);
}
__device__ __forceinline__ float fast_rcp(float x) { return __builtin_amdgcn_rcpf(x); }
__device__ __forceinline__ float sigmoidf_(float v) { return fast_rcp(1.0f + __expf(-v)); }
__device__ __forceinline__ float siluf_(float v) { return v * sigmoidf_(v); }
__device__ __forceinline__ float wave_sum(float v) {
#pragma unroll
    for (int o = 1; o < 64; o <<= 1) v += __shfl_xor(v, o);
    return v;
}

#define XB_TMO      128
#define XB_XCNT(j)  (256  + 64 * (j))
#define XB_XSUB(j)  (1280 + 64 * (j))
#define XB_XGEN(j)  (2304 + 64 * (j))
#define XB_TOP      3328
#define XB_TOPGEN   3392
#define XCD_BAR_WORDS 3456
#define XB_SPIN_CAP (1u << 20)
__device__ __forceinline__ unsigned xb_ld(unsigned* p)              { return __hip_atomic_load(p, __ATOMIC_RELAXED, __HIP_MEMORY_SCOPE_AGENT); }
__device__ __forceinline__ unsigned xb_add(unsigned* p, unsigned v) { return __hip_atomic_fetch_add(p, v, __ATOMIC_RELAXED, __HIP_MEMORY_SCOPE_AGENT); }
__device__ __forceinline__ unsigned xb_xcc_id() { return (unsigned)__builtin_amdgcn_s_getreg((3 << 11) | 20) & 0xFu; }
#define XB_SPIN(cond, bar) do { unsigned _sp = 0; while (cond) { __builtin_amdgcn_s_sleep(1); \
    if ((++_sp & 255u) == 0u) { if (xb_ld(&(bar)[XB_TMO])) break; if (_sp > XB_SPIN_CAP) { atomicAdd(&(bar)[XB_TMO], 1u); break; } } } } while (0)
struct XcdBarrier { unsigned* bar; unsigned x; volatile LAS unsigned* st; };
__device__ __forceinline__ XcdBarrier xcd_barrier_post(unsigned* bar, volatile LAS unsigned* st) {
    XcdBarrier b; b.bar = bar; b.x = xb_xcc_id(); b.st = st;
    if (threadIdx.x == 0) (void)xb_add(&bar[XB_XCNT(b.x)], 1u);
    return b;
}
__device__ __forceinline__ void xcd_barrier_complete(unsigned* bar, unsigned x, unsigned& nloc, unsigned& nx) {
    const unsigned G = gridDim.x * gridDim.y * gridDim.z;
    unsigned sum, cnt, mine, sp = 0u;
    for (;;) {
        sum = 0u; cnt = 0u; mine = 0u;
#pragma unroll
        for (unsigned j = 0; j < 16; ++j) { const unsigned c = xb_ld(&bar[XB_XCNT(j)]); sum += c; cnt += (c > 0u) ? 1u : 0u; mine = (j == x) ? c : mine; }
        if (sum == G) break;
        __builtin_amdgcn_s_sleep(1);
        if ((++sp & 255u) == 0u) { if (xb_ld(&bar[XB_TMO])) break; if (sp > XB_SPIN_CAP) { atomicAdd(&bar[XB_TMO], 1u); break; } }
    }
    nloc = mine > 0u ? mine : 1u; nx = cnt > 0u ? cnt : 1u;
}
__device__ __forceinline__ void xcd_barrier(const XcdBarrier& b) {
    asm volatile("s_waitcnt vmcnt(0)" ::: "memory");
    __syncthreads();
    if (threadIdx.x == 0) {
        unsigned* bar = b.bar;
        __builtin_amdgcn_s_waitcnt(0);
        unsigned nloc = b.st[0], nx = b.st[1];
        if (nloc == 0u) { xcd_barrier_complete(bar, b.x, nloc, nx); b.st[0] = nloc; b.st[1] = nx; }
        const unsigned old = xb_add(&bar[XB_XSUB(b.x)], 1u);
        const unsigned gen = old / nloc;
        if (old + 1u == (gen + 1u) * nloc) {
            __builtin_amdgcn_fence(__ATOMIC_RELEASE, "agent");
            asm volatile("s_waitcnt vmcnt(0)" ::: "memory");
            const unsigned og = xb_add(&bar[XB_TOP], 1u);
            const unsigned tg = og / nx;
            if (og + 1u == (tg + 1u) * nx) xb_add(&bar[XB_TOPGEN], 1u);
            else XB_SPIN(xb_ld(&bar[XB_TOPGEN]) == tg, bar);
            __builtin_amdgcn_fence(__ATOMIC_ACQUIRE, "agent");
            xb_add(&bar[XB_XGEN(b.x)], 1u);
            asm volatile("s_waitcnt vmcnt(0)" ::: "memory");
        } else {
            XB_SPIN(xb_ld(&bar[XB_XGEN(b.x)]) == gen, bar);
            __builtin_amdgcn_fence(__ATOMIC_ACQUIRE, "agent");
            asm volatile("s_waitcnt vmcnt(0)" ::: "memory");
        }
    }
    __syncthreads();
}

__device__ __forceinline__ int opaque_tid() { int t = threadIdx.x; asm volatile("" : "+v"(t)); return t; }
#define PHASE_TID(F) do { const int t_ = opaque_tid(); (F).tid = t_; (F).lane = t_ & 63; (F).wave = __builtin_amdgcn_readfirstlane(t_ >> 6); unsigned long long z_ = 0; asm volatile("" : "+s"((F).bx), "+s"((F).G), "+s"(z_)); (F).ws = (F).ws0 + z_; } while (0)
struct Args { const float* in[17]; float* out; unsigned char* ws; int ph_lo, ph_hi; };
struct Frame {
    LAS unsigned char* lds;
    gu32* ctl;
    unsigned char* ws; unsigned char* ws0;
    int tid, lane, wave, G, bx;
    float* out;
};

namespace gm {
constexpr int BM = 256, BK = 64, HALF = 128, HTB = HALF * BK * 2, NXCD = 8, WGM = 8;
__host__ __device__ __forceinline__ int lds_byte(int r, int c) { const int st = (r >> 4) * 2 + (c >> 5), rr = r & 15, cc = c & 31, ob = rr * 64 + cc * 2; return st * 1024 + (ob ^ (((ob >> 9) & 1) << 5)); }
__host__ __device__ __forceinline__ void stage_rc(int b, int& R, int& C) { const int st = b / 1024, sb = b % 1024, swz = sb ^ (((sb >> 9) & 1) << 5); R = (st >> 1) * 16 + swz / 64; C = (st & 1) * 32 + (swz % 64) / 2; }
__host__ __device__ __forceinline__ int perm32(int rho) { const int n = rho >> 4, i = rho & 15; return 8 * (i >> 2) + 4 * n + (i & 3); }

struct Unit { int pm, pn, e, aux, cnt; };

struct Order {
    int nM, nN, nwg, G, c;
    __device__ __forceinline__ void init(int nM_, int nN_, int G_, int c_) { nM = nM_; nN = nN_; nwg = nM * nN; G = G_; c = c_; }
    __device__ __forceinline__ bool next(int i, int& pm, int& pn) const {
        const long L = (long)i * G + c; if (L >= nwg) return false;
        int wgid = (int)L; { const int q = nwg / NXCD, r = nwg % NXCD, xcd = wgid % NXCD, off = wgid / NXCD; wgid = (xcd < r ? xcd * (q + 1) : r * (q + 1) + (xcd - r) * q) + off; }
        const int nig = WGM * nN, gid = wgid / nig, fm = gid * WGM, gsz = (nM - fm) < WGM ? (nM - fm) : WGM;
        pm = fm + ((wgid % nig) % gsz); pn = (wgid % nig) / gsz; return true;
    }
};

struct PlainPolicy {
    Order o; const bf16* Bt;
    __device__ __forceinline__ bool next(int i, Unit& u) const { u.e = 0; u.aux = 0; u.cnt = 256; return o.next(i, u.pm, u.pn); }
    __device__ __forceinline__ unsigned arow(const Unit& u, int r) const { return (unsigned)(u.pm * 256 + r); }
    __device__ __forceinline__ const bf16* bbase(const Unit&) const { return Bt; }
};
constexpr int NVO_OFF = 131072 + 8192;
constexpr int TILE_TAB_OFF = 131072;
struct FfnPolicy {
    Order o; const bf16* W; size_t wstride;
    const int* list; int moe; int gatherA; int tile0; LAS const int* tab;
    __device__ __forceinline__ bool next(int i, Unit& u) const {
        if (!o.next(i, u.pm, u.pn)) return false;
        int e = 0, aux = u.pm * 256, cnt = 256;
        if (moe) { const int T = tile0 + u.pm;
            const int w0 = __builtin_amdgcn_readfirstlane(tab[2 * T]), w1 = __builtin_amdgcn_readfirstlane(tab[2 * T + 1]);
            e = w0 & 15; cnt = w0 >> 4; aux = w1; }
        u.e = e; u.aux = aux; u.cnt = cnt; return true;
    }
    __device__ __forceinline__ unsigned arow(const Unit& u, int r) const {
        if (!gatherA) return (unsigned)(u.pm * 256 + r);
        if (!moe) return (unsigned)(u.aux + r);
        return (r < u.cnt) ? ((unsigned)list[(size_t)u.e * M + u.aux + r] >> 1) : 0u;
    }
    __device__ __forceinline__ const bf16* bbase(const Unit& u) const { return W + (size_t)u.e * wstride; }
};
struct EpiPlain {
    bf16* O; int ldc;
    __device__ __forceinline__ void operator()(const f32x4 (&acc)[2][2][4][2], const Unit& u, int wr, int wc, int fr, int fq) const {
        const int row0 = u.pm * BM + wr * 64 + fr, col0 = u.pn * BM + wc * 32 + 8 * fq;
#pragma unroll
        for (int ai = 0; ai < 2; ++ai)
#pragma unroll
            for (int m = 0; m < 4; ++m) { bf16* rowp = O + (size_t)(row0 + ai * HALF + m * 16) * ldc + col0;
#pragma unroll
                for (int bj = 0; bj < 2; ++bj) { const f32x4 v0 = acc[ai][bj][m][0], v1 = acc[ai][bj][m][1];
                    u32x4 w; w.x = cvt_pk_bf16(v0[0], v0[1]); w.y = cvt_pk_bf16(v0[2], v0[3]); w.z = cvt_pk_bf16(v1[0], v1[1]); w.w = cvt_pk_bf16(v1[2], v1[3]);
                    *(u32x4*)(rowp + bj * HALF) = w; } }
    }
};
struct EpiInproj {
    bf16* O; const float* lb; const float* gain;
    __device__ __forceinline__ void operator()(const f32x4 (&acc)[2][2][4][2], const Unit& u, int wr, int wc, int fr, int fq) const {
        const int row0 = u.pm * BM + wr * 64 + fr, col0 = u.pn * BM + wc * 32 + 8 * fq;
        const int kind = u.pn >> 1;
        float aux[2][8];
#pragma unroll
        for (int bj = 0; bj < 2; ++bj)
#pragma unroll
            for (int j = 0; j < 8; ++j) aux[bj][j] = 0.f;
        if (kind == 1) {
#pragma unroll
            for (int bj = 0; bj < 2; ++bj)
#pragma unroll
                for (int j = 0; j < 8; ++j) aux[bj][j] = lb[col0 - C_HG + bj * HALF + j];
        } else if (kind == 3) {
#pragma unroll
            for (int bj = 0; bj < 2; ++bj)
#pragma unroll
                for (int j = 0; j < 8; ++j) aux[bj][j] = gain[col0 - C_HGATE + bj * HALF + j];
        }
#pragma unroll
        for (int ai = 0; ai < 2; ++ai)
#pragma unroll
            for (int m = 0; m < 4; ++m) { bf16* rowp = O + (size_t)(row0 + ai * HALF + m * 16) * NPROJ + col0;
#pragma unroll
                for (int bj = 0; bj < 2; ++bj) {
                    float v[8];
#pragma unroll
                    for (int j = 0; j < 4; ++j) { v[j] = acc[ai][bj][m][0][j]; v[4 + j] = acc[ai][bj][m][1][j]; }
                    if (kind == 0) {
#pragma unroll
                        for (int j = 0; j < 8; ++j) v[j] = siluf_(v[j]);
                    } else if (kind == 1) {
#pragma unroll
                        for (int j = 0; j < 8; ++j) { const float l = aux[bj][j]; const float f = l + (1.0f - l) * sigmoidf_(v[j]); v[j] = fmaxf(__logf(f), -60.0f); }
                    } else if (kind == 3) {
#pragma unroll
                        for (int j = 0; j < 8; ++j) v[j] = siluf_(v[j]) * aux[bj][j];
                    } else if (kind == 4) {
#pragma unroll
                        for (int j = 0; j < 8; ++j) v[j] *= (0.125f * LOG2E);
                    }
                    u32x4 w; w.x = cvt_pk_bf16(v[0], v[1]); w.y = cvt_pk_bf16(v[2], v[3]); w.z = cvt_pk_bf16(v[4], v[5]); w.w = cvt_pk_bf16(v[6], v[7]);
                    *(u32x4*)(rowp + bj * HALF) = w; } }
    }
};
struct EpiInproj8 {
    bf16* O; const float* lb; const float* gain; const float* sa; const float* wmax;
    template <int KIND>
    __device__ __forceinline__ void run(const f32x4 (&acc)[2][2][4][2], const Unit& u, int wr, int wc, int fr, int fq) const {
        const int row0 = u.pm * BM + wr * 64 + fr, col0 = u.pn * BM + wc * 32 + 8 * fq;
        const float sa_lo = sa[u.pm * BM + wr * 64 + fr + 16 * fq], sa_hi = sa[u.pm * BM + HALF + wr * 64 + fr + 16 * fq];
#pragma unroll
        for (int bj = 0; bj < 2; ++bj) {
            f32x2_t sc2[4], aux2[4];
#pragma unroll
            for (int j = 0; j < 4; ++j) {
                const float k0 = (KIND == 4) ? (0.125f * LOG2E / 127.0f) : (1.0f / 127.0f);
                sc2[j] = (f32x2_t){wmax[col0 + bj * HALF + 2 * j] * k0, wmax[col0 + bj * HALF + 2 * j + 1] * k0};
                if (KIND == 1) aux2[j] = (f32x2_t){lb[col0 - C_HG + bj * HALF + 2 * j], lb[col0 - C_HG + bj * HALF + 2 * j + 1]};
                else if (KIND == 3) aux2[j] = (f32x2_t){gain[col0 - C_HGATE + bj * HALF + 2 * j], gain[col0 - C_HGATE + bj * HALF + 2 * j + 1]};
                else aux2[j] = (f32x2_t){0.f, 0.f};
            }
#pragma unroll
            for (int ai = 0; ai < 2; ++ai)
#pragma unroll
                for (int m = 0; m < 4; ++m) { const int row = row0 + ai * HALF + m * 16; const float a = __shfl(ai ? sa_hi : sa_lo, 16 * m + fr);
                    const f32x4 f0 = __builtin_convertvector(__builtin_bit_cast(i32x4, acc[ai][bj][m][0]), f32x4), f1 = __builtin_convertvector(__builtin_bit_cast(i32x4, acc[ai][bj][m][1]), f32x4);
                    f32x2_t v[4] = {(f32x2_t){f0[0], f0[1]}, (f32x2_t){f0[2], f0[3]}, (f32x2_t){f1[0], f1[1]}, (f32x2_t){f1[2], f1[3]}};
#pragma unroll
                    for (int j = 0; j < 4; ++j) {
                        v[j] = v[j] * (sc2[j] * (f32x2_t){a, a});
                        if (KIND == 0 || KIND == 1 || KIND == 3) {
                            const f32x2_t e = v[j] * (f32x2_t){-LOG2E, -LOG2E};
                            const f32x2_t dn = (f32x2_t){__builtin_amdgcn_exp2f(e[0]), __builtin_amdgcn_exp2f(e[1])} + (f32x2_t){1.0f, 1.0f};
                            const f32x2_t sg = (f32x2_t){fast_rcp(dn[0]), fast_rcp(dn[1])};
                            if (KIND == 0) v[j] = v[j] * sg;
                            else if (KIND == 3) v[j] = (v[j] * sg) * aux2[j];
                            else { const f32x2_t f = __builtin_elementwise_fma((f32x2_t){1.0f, 1.0f} - aux2[j], sg, aux2[j]);
                                v[j] = (f32x2_t){fmaxf(__logf(f[0]), -60.0f), fmaxf(__logf(f[1]), -60.0f)}; }
                        }
                    }
                    u32x4 w; w.x = cvt_pk_bf16(v[0][0], v[0][1]); w.y = cvt_pk_bf16(v[1][0], v[1][1]); w.z = cvt_pk_bf16(v[2][0], v[2][1]); w.w = cvt_pk_bf16(v[3][0], v[3][1]);
                    *(u32x4*)(O + (size_t)row * NPROJ + col0 + bj * HALF) = w; }
        }
    }
    __device__ __forceinline__ void operator()(const f32x4 (&acc)[2][2][4][2], const Unit& u, int wr, int wc, int fr, int fq) const {
        const int kind = u.pn >> 1;
        if (kind == 0) run<0>(acc, u, wr, wc, fr, fq);
        else if (kind == 1) run<1>(acc, u, wr, wc, fr, fq);
        else if (kind == 3) run<3>(acc, u, wr, wc, fr, fq);
        else if (kind == 4) run<4>(acc, u, wr, wc, fr, fq);
        else run<2>(acc, u, wr, wc, fr, fq);
    }
};
struct EpiGU {
    bf16* H; int ldh;
    __device__ __forceinline__ void operator()(const f32x4 (&acc)[2][2][4][2], const Unit& u, int wr, int wc, int fr, int fq) const {
        const int row0 = u.pm * BM + wr * 64 + fr, col0 = u.pn * HALF + wc * 32 + 8 * fq;
#pragma unroll
        for (int ai = 0; ai < 2; ++ai)
#pragma unroll
            for (int m = 0; m < 4; ++m) { bf16* rowp = H + (size_t)(row0 + ai * HALF + m * 16) * ldh + col0;
                float v[8];
#pragma unroll
                for (int j = 0; j < 4; ++j) { v[j] = siluf_(acc[ai][0][m][0][j]) * acc[ai][1][m][0][j]; v[4 + j] = siluf_(acc[ai][0][m][1][j]) * acc[ai][1][m][1][j]; }
                u32x4 w; w.x = cvt_pk_bf16(v[0], v[1]); w.y = cvt_pk_bf16(v[2], v[3]); w.z = cvt_pk_bf16(v[4], v[5]); w.w = cvt_pk_bf16(v[6], v[7]);
                *(u32x4*)rowp = w; }
    }
};
struct EpiGU8 {
    unsigned char* H; int ldh;
    __device__ __forceinline__ void operator()(const f32x4 (&acc)[2][2][4][2], const Unit& u, int wr, int wc, int fr, int fq) const {
        const int row0 = u.pm * BM + wr * 64 + fr, col0 = u.pn * HALF + wc * 32 + 8 * fq;
        constexpr float isc = 1.0f / (H2_SCALE * WGU_SCALE);
        constexpr float IC = 1.0f / (isc * isc * HID_SCALE);
        static_assert(IC == 65536.0f, "log2(1/c) below assumes these scales");
        constexpr float LG_IC = 16.0f;
#pragma unroll
        for (int ai = 0; ai < 2; ++ai)
#pragma unroll
            for (int m = 0; m < 4; ++m) {
                unsigned char* rowp = H + (size_t)(row0 + ai * HALF + m * 16) * ldh + col0;
                float v[8];
#pragma unroll
                for (int n = 0; n < 2; ++n)
#pragma unroll
                    for (int h = 0; h < 2; ++h) {
                        const f32x2_t g2 = {acc[ai][0][m][n][2 * h], acc[ai][0][m][n][2 * h + 1]}, u2 = {acc[ai][1][m][n][2 * h], acc[ai][1][m][n][2 * h + 1]};
                        const f32x2_t gu = g2 * u2;
                        const f32x2_t ex = __builtin_elementwise_fma(g2, (f32x2_t){-isc * LOG2E, -isc * LOG2E}, (f32x2_t){LG_IC, LG_IC});
                        const f32x2_t dn = (f32x2_t){__builtin_amdgcn_exp2f(ex[0]), __builtin_amdgcn_exp2f(ex[1])} + (f32x2_t){IC, IC};
                        const f32x2_t o2 = gu * (f32x2_t){fast_rcp(dn[0]), fast_rcp(dn[1])};
                        v[4 * n + 2 * h] = o2[0]; v[4 * n + 2 * h + 1] = o2[1];
                    }
                int p0 = pk_fp8(v[0], v[1], 0, false); p0 = pk_fp8(v[2], v[3], p0, true);
                int p1 = pk_fp8(v[4], v[5], 0, false); p1 = pk_fp8(v[6], v[7], p1, true);
                *(u32x2*)rowp = (u32x2){(unsigned)p0, (unsigned)p1}; }
    }
};
struct EpiDown {
    bf16* Y; const int* list; int moe; float osc;
    __device__ __forceinline__ void operator()(const f32x4 (&acc)[2][2][4][2], const Unit& u, int wr, int wc, int fr, int fq) const {
        const int r0 = wr * 64 + fr, col0 = u.pn * BM + wc * 32 + 8 * fq;
#pragma unroll
        for (int ai = 0; ai < 2; ++ai)
#pragma unroll
            for (int m = 0; m < 4; ++m) { const int r = r0 + ai * HALF + m * 16;
                size_t drow; bool ok = true;
                if (moe) { ok = r < u.cnt; drow = ok ? (size_t)(unsigned)list[(size_t)u.e * M + u.aux + r] : 0; } else drow = (size_t)(u.pm * BM + r);
                bf16* rowp = Y + drow * D + col0;
#pragma unroll
                for (int bj = 0; bj < 2; ++bj) { const f32x4 v0 = acc[ai][bj][m][0] * osc, v1 = acc[ai][bj][m][1] * osc;
                    u32x4 w; w.x = cvt_pk_bf16(v0[0], v0[1]); w.y = cvt_pk_bf16(v0[2], v0[3]); w.z = cvt_pk_bf16(v1[0], v1[1]); w.w = cvt_pk_bf16(v1[2], v1[3]);
                    if (ok) *(u32x4*)(rowp + bj * HALF) = w; } }
    }
};

template <bool GATHER, class Epi, class Pol, int MODE = 0>
__device__ __forceinline__ void gemm_phase(LAS unsigned char* lds, const bf16* A, int K, const Pol& S, const Epi& E) {
    const int tid = opaque_tid(), wid = __builtin_amdgcn_readfirstlane(tid >> 6), lane = tid & 63, wr = wid >> 2, wc = wid & 3, fr = lane & 15, fq = lane >> 4;
    const int nt = K / BK;
    int R0, C0; stage_rc(tid * 16, R0, C0);
    const unsigned voffB0 = (unsigned)(((R0 & ~31) + perm32(R0 & 31)) * K + C0) * 2u, voffA0 = (unsigned)(R0 * K + C0) * 2u, vstep64 = (unsigned)(64 * K) * 2u;
    const size_t kstep = (size_t)(BK * 2);
    const size_t hstep = (size_t)HALF * K * 2;
    const size_t tstep = 2 * hstep;
    const unsigned ldsw = (unsigned)wid * 1024u;
    const int aoff = lds_byte(wr * 64 + fr, fq * 8), boff = lds_byte(wc * 32 + fr, fq * 8);
#define G_SA(b, h) (((b) * 2 + (h)) * HTB)
#define G_SB(b, h) ((4 + (b) * 2 + (h)) * HTB)
#define G_GLDS(gptr, ldsoff) __builtin_amdgcn_global_load_lds((const unsigned*)(gptr), (LAS unsigned*)(lds + (ldsoff)), 16, 0, 0)
#define G_STAGE_B(bufoff, gbase) do { G_GLDS((const char*)(gbase) + voffB0, (bufoff) + ldsw); G_GLDS((const char*)(gbase) + vstep64 + voffB0, (bufoff) + ldsw + 8192); } while (0)
#define G_STAGE_A(bufoff, kofs, v0, v1) do { G_GLDS((const char*)A + (kofs) + (v0), (bufoff) + ldsw); G_GLDS((const char*)A + (kofs) + (v1), (bufoff) + ldsw + 8192); } while (0)
#define G_STAGE_AU(bufoff, gbase) do { G_GLDS((const char*)(gbase) + voffA0, (bufoff) + ldsw); G_GLDS((const char*)(gbase) + vstep64 + voffA0, (bufoff) + ldsw + 8192); } while (0)
#define G_LDA(dst, b, h) do { _Pragma("unroll") for (int m = 0; m < 4; ++m) _Pragma("unroll") for (int k = 0; k < 2; ++k) dst[m][k] = *(const LAS bf16x8*)(lds + G_SA(b, h) + aoff + m * 2048 + k * 1024); } while (0)
#define G_LDB(dst, b, h) do { _Pragma("unroll") for (int n = 0; n < 2; ++n) _Pragma("unroll") for (int k = 0; k < 2; ++k) dst[n][k] = *(const LAS bf16x8*)(lds + G_SB(b, h) + boff + n * 2048 + k * 1024); } while (0)
#define G_MMA(ai, bj, At, Bt) do { __builtin_amdgcn_s_setprio(1); \
        _Pragma("unroll") for (int m = 0; m < 4; ++m) _Pragma("unroll") for (int n = 0; n < 2; ++n) _Pragma("unroll") for (int k = 0; k < 2; ++k) { \
            if constexpr (MODE == 1) acc[ai][bj][m][n] = __builtin_bit_cast(f32x4, __builtin_amdgcn_mfma_i32_16x16x64_i8(__builtin_bit_cast(i32x4, Bt[n][k]), __builtin_bit_cast(i32x4, At[m][k]), __builtin_bit_cast(i32x4, acc[ai][bj][m][n]), 0, 0, 0)); \
            else acc[ai][bj][m][n] = __builtin_amdgcn_mfma_f32_16x16x32_bf16(Bt[n][k], At[m][k], acc[ai][bj][m][n], 0, 0, 0); } \
        __builtin_amdgcn_s_setprio(0); } while (0)
#define G_LD8(p) __builtin_shufflevector(*(const LAS i32x4*)(p), *(const LAS i32x4*)((p) + 1024), 0, 1, 2, 3, 4, 5, 6, 7)
#define G_LDA8(dst, b, h) do { _Pragma("unroll") for (int m = 0; m < 4; ++m) dst[m] = G_LD8(lds + G_SA(b, h) + aoff + m * 2048); } while (0)
#define G_LDB8(dst, b, h) do { _Pragma("unroll") for (int n = 0; n < 2; ++n) dst[n] = G_LD8(lds + G_SB(b, h) + boff + n * 2048); } while (0)
#define G_MMA8(ai, bj, A8, B8) do { __builtin_amdgcn_s_setprio(1); _Pragma("unroll") for (int m = 0; m < 4; ++m) _Pragma("unroll") for (int n = 0; n < 2; ++n) \
        asm volatile("v_mfma_scale_f32_16x16x128_f8f6f4 %0, %1, %2, %0, %3, %3 op_sel_hi:[0,0,0]" : "+v"(acc[ai][bj][m][n]) : "v"(B8[n]), "v"(A8[m]), "v"(scl8)); __builtin_amdgcn_s_setprio(0); } while (0)
#define X_LDA(b, h) do { if constexpr (MODE == 2) G_LDA8(A8, b, h); else G_LDA(At, b, h); } while (0)
#define X_LDB0(b, h) do { if constexpr (MODE == 2) G_LDB8(B08, b, h); else G_LDB(B0, b, h); } while (0)
#define X_LDB1(b, h) do { if constexpr (MODE == 2) G_LDB8(B18, b, h); else G_LDB(B1, b, h); } while (0)
#define X_MMA0(ai, bj) do { if constexpr (MODE == 2) G_MMA8(ai, bj, A8, B08); else G_MMA(ai, bj, At, B0); } while (0)
#define X_MMA1(ai, bj) do { if constexpr (MODE == 2) G_MMA8(ai, bj, A8, B18); else G_MMA(ai, bj, At, B1); } while (0)
#define G_WAIT_V(n) asm volatile("s_waitcnt vmcnt(" #n ")" ::: "memory")
#define G_WAIT_L(n) asm volatile("s_waitcnt lgkmcnt(" #n ")" ::: "memory")
#define G_BAR __builtin_amdgcn_s_barrier()
#define G_SCHED __builtin_amdgcn_sched_barrier(0)
#define G_VOA(dst, u) do { _Pragma("unroll") for (int h = 0; h < 2; ++h) _Pragma("unroll") for (int i = 0; i < 2; ++i) dst[h][i] = (S.arow(u, h * HALF + R0 + 64 * i) * (unsigned)K + (unsigned)C0) * 2u; } while (0)
    Unit cur, nxt; int ui = 0;
    if (!S.next(0, cur)) return;
    f32x4 acc[2][2][4][2];
#pragma unroll
    for (int a = 0; a < 2; ++a)
#pragma unroll
        for (int b = 0; b < 2; ++b)
#pragma unroll
            for (int m = 0; m < 4; ++m)
#pragma unroll
                for (int n = 0; n < 2; ++n) acc[a][b][m][n] = (f32x4){0.f, 0.f, 0.f, 0.f};
    bf16x8 At[4][2], B0[2][2], B1[2][2];
    i32x8 A8[4], B08[2], B18[2];
    const int scl8 = 0x7f7f7f7f;
    const char* cB = (const char*)S.bbase(cur) + (size_t)cur.pn * tstep;
    if constexpr (GATHER) {
    unsigned vo[2][2];
    LAS u32x4* nvo_l = (LAS u32x4*)(lds + NVO_OFF) + tid;
    G_VOA(vo, cur);
    G_STAGE_B(G_SB(0, 0), cB); G_STAGE_B(G_SB(0, 1), cB + hstep); G_STAGE_A(G_SA(0, 0), 0, vo[0][0], vo[0][1]); G_STAGE_A(G_SA(0, 1), 0, vo[1][0], vo[1][1]);
    if (wr == 1) G_BAR;
    G_WAIT_V(2); G_BAR;
    G_STAGE_B(G_SB(1, 0), cB + kstep); G_STAGE_A(G_SA(1, 0), kstep, vo[0][0], vo[0][1]); G_STAGE_B(G_SB(1, 1), cB + hstep + kstep);
    G_WAIT_V(6); G_BAR;
    for (;;) {
        const bool has_next = S.next(ui + 1, nxt);
        const char* nB = cB;
        { unsigned nvo[2][2];
          if (has_next) { G_VOA(nvo, nxt); nB = (const char*)S.bbase(nxt) + (size_t)nxt.pn * tstep; }
          else {
#pragma unroll
            for (int h = 0; h < 2; ++h)
#pragma unroll
                for (int i = 0; i < 2; ++i) nvo[h][i] = vo[h][i];
          }
          *nvo_l = (u32x4){nvo[0][0], nvo[0][1], nvo[1][0], nvo[1][1]}; }
        for (int t = 0; t < nt; t += 2) {
            const bool last = (t == nt - 2);
            const size_t k1 = (size_t)(t + 1) * kstep;
            const size_t k2 = last ? 0 : (size_t)(t + 2) * kstep;
            const char* b2 = last ? nB : cB + (size_t)(t + 2) * kstep;
            const char* b3 = b2 + kstep;
            unsigned w00 = vo[0][0], w01 = vo[0][1], w10 = vo[1][0], w11 = vo[1][1];
            if (last) { const u32x4 nv = *nvo_l; w00 = nv[0]; w01 = nv[1]; w10 = nv[2]; w11 = nv[3]; }
            X_LDB0(0, 0); X_LDB1(0, 1); G_SCHED; X_LDA(0, 0); G_STAGE_A(G_SA(1, 1), k1, vo[1][0], vo[1][1]);
            G_WAIT_V(8); G_WAIT_L(0); G_BAR; X_MMA0(0, 0); X_MMA1(0, 1); G_BAR; G_SCHED;
            X_LDA(0, 1); G_STAGE_B(G_SB(0, 0), b2); G_STAGE_B(G_SB(0, 1), b2 + hstep); G_STAGE_A(G_SA(0, 0), k2, w00, w01);
            G_WAIT_V(8); G_WAIT_L(0); G_BAR; X_MMA0(1, 0); X_MMA1(1, 1); G_BAR; G_SCHED;
            X_LDB0(1, 0); X_LDB1(1, 1); G_SCHED; X_LDA(1, 0); G_STAGE_A(G_SA(0, 1), k2, w10, w11);
            G_WAIT_V(8); G_WAIT_L(0); G_BAR; X_MMA0(0, 0); X_MMA1(0, 1); G_BAR; G_SCHED;
            X_LDA(1, 1); G_STAGE_B(G_SB(1, 0), b3); G_STAGE_B(G_SB(1, 1), b3 + hstep); G_STAGE_A(G_SA(1, 0), k2 + kstep, w00, w01);
            G_WAIT_V(8); G_WAIT_L(0); G_BAR; X_MMA0(1, 0); X_MMA1(1, 1); G_BAR; G_SCHED;
        }
        if (wr == 0) G_BAR;
        E(acc, cur, wr, wc, fr, fq);
        if (!has_next) break;
#pragma unroll
        for (int a = 0; a < 2; ++a)
#pragma unroll
            for (int b = 0; b < 2; ++b)
#pragma unroll
                for (int m = 0; m < 4; ++m)
#pragma unroll
                    for (int n = 0; n < 2; ++n) acc[a][b][m][n] = (f32x4){0.f, 0.f, 0.f, 0.f};
        cur = nxt; cB = nB; ++ui;
        { const u32x4 nv = *nvo_l; vo[0][0] = nv[0]; vo[0][1] = nv[1]; vo[1][0] = nv[2]; vo[1][1] = nv[3]; }
        if (wr == 1) G_BAR;
    }
    } else {
    const char* cA = (const char*)A + (size_t)S.arow(cur, 0) * (size_t)K * 2;
    G_STAGE_B(G_SB(0, 0), cB); G_STAGE_B(G_SB(0, 1), cB + hstep); G_STAGE_AU(G_SA(0, 0), cA); G_STAGE_AU(G_SA(0, 1), cA + hstep);
    if (wr == 1) G_BAR;
    G_WAIT_V(2); G_BAR;
    G_STAGE_B(G_SB(1, 0), cB + kstep); G_STAGE_AU(G_SA(1, 0), cA + kstep); G_STAGE_B(G_SB(1, 1), cB + hstep + kstep);
    G_WAIT_V(6); G_BAR;
    for (;;) {
        const bool has_next = S.next(ui + 1, nxt);
        const char* nA = has_next ? (const char*)A + (size_t)S.arow(nxt, 0) * (size_t)K * 2 : cA; const char* nB = has_next ? (const char*)S.bbase(nxt) + (size_t)nxt.pn * tstep : cB;
        for (int t = 0; t < nt; t += 2) {
            const bool last = (t == nt - 2);
            const char* a1 = cA + (size_t)(t + 1) * kstep;
            const char* a2 = last ? nA : cA + (size_t)(t + 2) * kstep; const char* b2 = last ? nB : cB + (size_t)(t + 2) * kstep;
            const char* a3 = a2 + kstep; const char* b3 = b2 + kstep;
            X_LDB0(0, 0); X_LDB1(0, 1); G_SCHED; X_LDA(0, 0); G_STAGE_AU(G_SA(1, 1), a1 + hstep);
            G_WAIT_V(8); G_WAIT_L(0); G_BAR; X_MMA0(0, 0); X_MMA1(0, 1); G_BAR; G_SCHED;
            X_LDA(0, 1); G_STAGE_B(G_SB(0, 0), b2); G_STAGE_B(G_SB(0, 1), b2 + hstep); G_STAGE_AU(G_SA(0, 0), a2);
            G_WAIT_V(8); G_WAIT_L(0); G_BAR; X_MMA0(1, 0); X_MMA1(1, 1); G_BAR; G_SCHED;
            X_LDB0(1, 0); X_LDB1(1, 1); G_SCHED; X_LDA(1, 0); G_STAGE_AU(G_SA(0, 1), a2 + hstep);
            G_WAIT_V(8); G_WAIT_L(0); G_BAR; X_MMA0(0, 0); X_MMA1(0, 1); G_BAR; G_SCHED;
            X_LDA(1, 1); G_STAGE_B(G_SB(1, 0), b3); G_STAGE_B(G_SB(1, 1), b3 + hstep); G_STAGE_AU(G_SA(1, 0), a3);
            G_WAIT_V(8); G_WAIT_L(0); G_BAR; X_MMA0(1, 0); X_MMA1(1, 1); G_BAR; G_SCHED;
        }
        if (wr == 0) G_BAR;
        E(acc, cur, wr, wc, fr, fq);
        if (!has_next) break;
#pragma unroll
        for (int a = 0; a < 2; ++a)
#pragma unroll
            for (int b = 0; b < 2; ++b)
#pragma unroll
                for (int m = 0; m < 4; ++m)
#pragma unroll
                    for (int n = 0; n < 2; ++n) acc[a][b][m][n] = (f32x4){0.f, 0.f, 0.f, 0.f};
        cur = nxt; cA = nA; cB = nB; ++ui;
        if (wr == 1) G_BAR;
    }
    }
    G_WAIT_V(0);
    G_BAR;
#undef G_SA
#undef G_SB
#undef G_GLDS
#undef G_STAGE_A
#undef G_STAGE_AU
#undef G_STAGE_B
#undef G_LDA
#undef G_LDB
#undef G_MMA
#undef G_LD8
#undef G_LDA8
#undef G_LDB8
#undef G_MMA8
#undef X_LDA
#undef X_LDB0
#undef X_LDB1
#undef X_MMA0
#undef X_MMA1
#undef G_WAIT_V
#undef G_WAIT_L
#undef G_BAR
#undef G_SCHED
#undef G_VOA
}
}

__device__ __forceinline__ void transpose_item(const float* W, int K, int N, bf16* WT, int row_off, int ileave, LAS float* scr, int item, int lane) {
    const int nblk = N / 32, kb = item / nblk, nb = item % nblk, k0 = 64 * kb, n0 = 32 * nb;
#pragma unroll
    for (int i = 0; i < 32; ++i) { const int kk = 2 * i + (lane >> 5); scr[kk * 33 + (lane & 31)] = W[(size_t)(k0 + kk) * N + n0 + (lane & 31)]; }
    LDS_WAIT(); asm volatile("" ::: "memory");
    const int c = lane & 7;
    const int drow0 = row_off + (ileave ? (((n0 >> 7) << 8) + (n0 & 127)) : n0);
#pragma unroll
    for (int j = 0; j < 4; ++j) { const int n = (lane >> 3) + 8 * j; const LAS float* s = scr + (8 * c) * 33 + n;
        u32x4 o; o.x = pk2(s[0 * 33], s[1 * 33]); o.y = pk2(s[2 * 33], s[3 * 33]); o.z = pk2(s[4 * 33], s[5 * 33]); o.w = pk2(s[6 * 33], s[7 * 33]);
        *(GAS u32x4*)(WT + (size_t)(drow0 + n) * K + k0 + 8 * c) = o; }
    LDS_WAIT(); asm volatile("" ::: "memory");
}
__device__ __forceinline__ void transpose8_item(const float* W, int K, int N, unsigned char* WT, int row_off, int ileave, float wsc, LAS float* scr, int item, int lane) {
    const int nblk = N / 32, kb = item / nblk, nb = item % nblk, k0 = 64 * kb, n0 = 32 * nb;
#pragma unroll
    for (int i = 0; i < 32; ++i) { const int kk = 2 * i + (lane >> 5); scr[kk * 33 + (lane & 31)] = W[(size_t)(k0 + kk) * N + n0 + (lane & 31)]; }
    LDS_WAIT(); asm volatile("" ::: "memory");
    const int c = lane & 3;
    const int drow0 = row_off + (ileave ? (((n0 >> 7) << 8) + (n0 & 127)) : n0);
#pragma unroll
    for (int j = 0; j < 2; ++j) { const int n = (lane >> 2) + 16 * j; const LAS float* sp = scr + (16 * c) * 33 + n;
        unsigned w[4];
#pragma unroll
        for (int q = 0; q < 4; ++q) { int p = pk_fp8(sp[(4 * q) * 33] * wsc, sp[(4 * q + 1) * 33] * wsc, 0, false);
            p = pk_fp8(sp[(4 * q + 2) * 33] * wsc, sp[(4 * q + 3) * 33] * wsc, p, true); w[q] = (unsigned)p; }
        *(GAS u32x4*)(WT + (size_t)(drow0 + n) * K + k0 + 16 * c) = (u32x4){w[0], w[1], w[2], w[3]}; }
    LDS_WAIT(); asm volatile("" ::: "memory");
}
__device__ __forceinline__ void absmax_item(const float* W, int N, gu32* wmax, int item, int lane) {
    const int nblk = N / 32, kb = item / nblk, nb = item % nblk, k0 = 64 * kb, n0 = 32 * nb;
    float v[32];
#pragma unroll
    for (int i = 0; i < 32; ++i) { const int kk = 2 * i + (lane >> 5); v[i] = W[(size_t)(k0 + kk) * N + n0 + (lane & 31)]; }
    float am = 0.f;
#pragma unroll
    for (int i = 0; i < 32; ++i) am = fmaxf(am, fabsf(v[i]));
    am = fmaxf(am, __shfl_xor(am, 32));
    if (lane < 32) __hip_atomic_fetch_max((unsigned*)(wmax + n0 + lane), __builtin_bit_cast(unsigned, am), RLX_AGENT);
}
__device__ __forceinline__ void quant8_item(const float* W, int K, int N, signed char* WT, const gu32* wmax, LAS float* scr, int item, int lane) {
    const int nblk = N / 32, kb = item / nblk, nb = item % nblk, k0 = 64 * kb, n0 = 32 * nb;
#pragma unroll
    for (int i = 0; i < 32; ++i) { const int kk = 2 * i + (lane >> 5); scr[kk * 33 + (lane & 31)] = W[(size_t)(k0 + kk) * N + n0 + (lane & 31)]; }
    LDS_WAIT(); asm volatile("" ::: "memory");
    const int c = lane & 3;
#pragma unroll
    for (int j = 0; j < 2; ++j) { const int n = (lane >> 2) + 16 * j; const LAS float* sp = scr + (16 * c) * 33 + n;
        const float am = __builtin_bit_cast(float, __hip_atomic_load((unsigned*)(wmax + n0 + n), RLX_AGENT));
        const float inv = 127.0f / fmaxf(am, 1e-30f);
        unsigned w[4];
#pragma unroll
        for (int q = 0; q < 4; ++q) { unsigned pk = 0;
#pragma unroll
            for (int i = 0; i < 4; ++i) pk |= ((unsigned)(int)rintf(sp[(4 * q + i) * 33] * inv) & 0xffu) << (8 * i);
            w[q] = pk; }
        *(GAS u32x4*)(WT + (size_t)(n0 + n) * K + k0 + 16 * c) = (u32x4){w[0], w[1], w[2], w[3]}; }
    LDS_WAIT(); asm volatile("" ::: "memory");
}
__device__ __forceinline__ void conv_win(Frame& F, const Args& args, int layer) {
    PHASE_TID(F);
    LAS float* scr = (LAS float*)(F.lds + F.wave * 16384);
    const int gw = F.bx * NWAVES + F.wave, NGW = F.G * NWAVES;
    constexpr int I_IN = (D / 64) * (NPROJ / 32);
    for (int it = gw; it < I_IN; it += NGW) quant8_item(args.in[4] + (size_t)layer * D * NPROJ, D, NPROJ, (signed char*)(F.ws + WS_WIN), F.ctl + CW_WMAX + layer * NPROJ, scr, it, F.lane);
}
__device__ __forceinline__ void win_absmax_all(Frame& F, const Args& args) {
    PHASE_TID(F);
    const int gw = F.bx * NWAVES + F.wave, NGW = F.G * NWAVES;
    constexpr int I_IN = (D / 64) * (NPROJ / 32);
    float rg[32];
#define AM_LOAD(itv, dst) do { const int l_ = (itv) / I_IN, r_ = (itv) % I_IN, kb_ = r_ / (NPROJ / 32), nb_ = r_ % (NPROJ / 32); \
        const float* wp_ = args.in[4] + (size_t)l_ * D * NPROJ + (size_t)(64 * kb_ + (F.lane >> 5)) * NPROJ + 32 * nb_ + (F.lane & 31); \
        _Pragma("unroll") for (int i_ = 0; i_ < 32; ++i_) dst[i_] = wp_[(size_t)(2 * i_) * NPROJ]; } while (0)
    if (gw < DEPTH * I_IN) AM_LOAD(gw, rg);
    for (int it = gw; it < DEPTH * I_IN; it += NGW) {
        float nrg[32]; const bool hn = it + NGW < DEPTH * I_IN;
        if (hn) AM_LOAD(it + NGW, nrg);
        const int l = it / I_IN, r = it % I_IN, nb = r % (NPROJ / 32);
        float am = 0.f;
#pragma unroll
        for (int i = 0; i < 32; ++i) am = fmaxf(am, fabsf(rg[i]));
        am = fmaxf(am, __shfl_xor(am, 32));
        if (F.lane < 32) __hip_atomic_fetch_max((unsigned*)(F.ctl + CW_WMAX + l * NPROJ + 32 * nb + F.lane), __builtin_bit_cast(unsigned, am), RLX_AGENT);
        if (hn) {
#pragma unroll
            for (int i = 0; i < 32; ++i) rg[i] = nrg[i]; }
    }
#undef AM_LOAD
}
struct ConvItem { const float* W; unsigned char* WT; int K, N, row_off, ileave, kind, item; float wsc; };
#define CONV_LOAD(ci, rg) do { const int nblk_ = (ci).N / 32, kb_ = (ci).item / nblk_, nb_ = (ci).item % nblk_; const float* wp_ = (ci).W + (size_t)(64 * kb_ + (F.lane >> 5)) * (ci).N + 32 * nb_ + (F.lane & 31); \
        _Pragma("unroll") for (int i_ = 0; i_ < 32; ++i_) rg[i_] = wp_[(size_t)(2 * i_) * (ci).N]; } while (0)
__device__ __forceinline__ void conv_finish(const ConvItem& ci, const float (&rg)[32], LAS float* scr, int lane) {
    const int nblk = ci.N / 32, kb = ci.item / nblk, nb = ci.item % nblk, k0 = 64 * kb, n0 = 32 * nb;
#pragma unroll
    for (int i = 0; i < 32; ++i) { const int kk = 2 * i + (lane >> 5); scr[kk * 33 + (lane & 31)] = rg[i]; }
    LDS_WAIT(); asm volatile("" ::: "memory");
    const int drow0 = ci.row_off + (ci.ileave ? (((n0 >> 7) << 8) + (n0 & 127)) : n0);
    if (ci.kind == 0) {
        const int c = lane & 7; bf16* WT = (bf16*)ci.WT;
#pragma unroll
        for (int j = 0; j < 4; ++j) { const int n = (lane >> 3) + 8 * j; const LAS float* sp = scr + (8 * c) * 33 + n;
            u32x4 o; o.x = pk2(sp[0 * 33], sp[1 * 33]); o.y = pk2(sp[2 * 33], sp[3 * 33]); o.z = pk2(sp[4 * 33], sp[5 * 33]); o.w = pk2(sp[6 * 33], sp[7 * 33]);
            *(GAS u32x4*)(WT + (size_t)(drow0 + n) * ci.K + k0 + 8 * c) = o; }
    } else {
        const int c = lane & 3; const float wsc = ci.wsc;
#pragma unroll
        for (int j = 0; j < 2; ++j) { const int n = (lane >> 2) + 16 * j; const LAS float* sp = scr + (16 * c) * 33 + n;
            unsigned w[4];
#pragma unroll
            for (int q = 0; q < 4; ++q) { int pq = pk_fp8(sp[(4 * q) * 33] * wsc, sp[(4 * q + 1) * 33] * wsc, 0, false);
                pq = pk_fp8(sp[(4 * q + 2) * 33] * wsc, sp[(4 * q + 3) * 33] * wsc, pq, true); w[q] = (unsigned)pq; }
            *(GAS u32x4*)(ci.WT + (size_t)(drow0 + n) * ci.K + k0 + 16 * c) = (u32x4){w[0], w[1], w[2], w[3]}; }
    }
    LDS_WAIT(); asm volatile("" ::: "memory");
}
__device__ __forceinline__ void conv_layer(Frame& F, const Args& args, int layer) {
    PHASE_TID(F);
    LAS float* scr = (LAS float*)(F.lds + F.wave * 16384);
    const int gw = F.bx * NWAVES + F.wave, NGW = F.G * NWAVES;
    unsigned char* WOUT = (unsigned char*)(F.ws + WS_WOUT); unsigned char* WDN = (unsigned char*)(F.ws + WS_WDN); unsigned char* WGU8 = (unsigned char*)(F.ws + WS_WGU);
    const int j = layer >> 1, moe = layer & 1;
    constexpr int I_OUT = (D / 64) * (D / 32);
    constexpr int I_QD = (D / 64) * (DFF / 32), I_DD = (DFF / 64) * (D / 32);
    constexpr int I_QE = (D / 64) * (DFFE / 32), I_DE = (DFFE / 64) * (D / 32);
    const int NIT = moe ? (NE * 2 * I_QE + I_OUT + NE * I_DE) : (2 * I_QD + I_OUT + I_DD);
    auto decode = [&](int it) __attribute__((always_inline)) -> ConvItem {
        ConvItem ci; int r = it;
        if (!moe) {
            if (r < 2 * I_QD) { const int up = r >= I_QD; ci = ConvItem{(up ? args.in[9] : args.in[8]) + (size_t)j * D * DFF, WGU8, D, DFF, up ? 128 : 0, 1, 1, up ? r - I_QD : r, WGU_SCALE}; return ci; } r -= 2 * I_QD;
            if (r < I_OUT) { ci = ConvItem{args.in[5] + (size_t)layer * D * D, WOUT, D, D, 0, 0, 0, r, 1.0f}; return ci; } r -= I_OUT;
            ci = ConvItem{args.in[10] + (size_t)j * DFF * D, WDN, DFF, D, 0, 0, 1, r, WDN_SCALE}; return ci;
        }
        if (r < NE * 2 * I_QE) { const int e = r / (2 * I_QE), q = r % (2 * I_QE), up = q >= I_QE; const size_t we = ((size_t)j * NE + e) * (size_t)D * DFFE;
            ci = ConvItem{(up ? args.in[13] : args.in[12]) + we, WGU8 + (size_t)e * 2 * DFFE * D, D, DFFE, up ? 128 : 0, 1, 1, up ? q - I_QE : q, WGU_SCALE}; return ci; } r -= NE * 2 * I_QE;
        if (r < I_OUT) { ci = ConvItem{args.in[5] + (size_t)layer * D * D, WOUT, D, D, 0, 0, 0, r, 1.0f}; return ci; } r -= I_OUT;
        const int e = r / I_DE; r -= e * I_DE; const size_t we = ((size_t)j * NE + e) * (size_t)D * DFFE;
        ci = ConvItem{args.in[14] + we, WDN + (size_t)e * D * DFFE, DFFE, D, 0, 0, 1, r, WDN_SCALE}; return ci;
    };
    ConvItem cur; float rg[32];
    if (gw < NIT) { cur = decode(gw); CONV_LOAD(cur, rg); }
    for (int it = gw; it < NIT; it += NGW) {
        ConvItem nxt; float nrg[32]; const bool hn = it + NGW < NIT;
        if (hn) { nxt = decode(it + NGW); CONV_LOAD(nxt, nrg); }
        conv_finish(cur, rg, scr, F.lane);
        if (hn) { cur = nxt;
#pragma unroll
            for (int i = 0; i < 32; ++i) rg[i] = nrg[i]; }
    }
}
__device__ __forceinline__ void pre_phase(Frame& F, const Args& args) {
    PHASE_TID(F);
    LAS float* sc = (LAS float*)F.lds;
    LAS float* red = (LAS float*)(F.lds + 65536);
    const float* c = args.in[1];
    for (int i = F.tid; i < NB * D; i += NTHR) { const int b = i >> 10, k = i & 1023; sc[k * 16 + b] = siluf_(c[i]); }
    __syncthreads();
    float* mod = (float*)(F.ws + WS_MOD);
    for (int item = F.bx; item < 8 * 48; item += F.G) {
        const int ls = item / 48, j0 = (item % 48) * 64;
        const float* W = args.in[2] + (size_t)ls * D * 3072;
        float a[16];
#pragma unroll
        for (int b = 0; b < 16; ++b) a[b] = 0.f;
        const int kb = F.wave * 128;
        const float* wp = W + (size_t)kb * 3072 + j0 + F.lane;
        float wv[16];
#pragma unroll
        for (int i = 0; i < 16; ++i) wv[i] = wp[(size_t)i * 3072];
#pragma unroll 1
        for (int k0 = 0; k0 < 128; k0 += 16) {
            float wn[16];
            if (k0 + 16 < 128) {
#pragma unroll
                for (int i = 0; i < 16; ++i) wn[i] = wp[(size_t)(k0 + 16 + i) * 3072]; }
#pragma unroll
            for (int i = 0; i < 16; ++i) {
                const float w = wv[i];
                const LAS f32x4* s4 = (const LAS f32x4*)(sc + (kb + k0 + i) * 16);
#pragma unroll
                for (int q = 0; q < 4; ++q) { const f32x4 s = s4[q]; a[4 * q + 0] += s[0] * w; a[4 * q + 1] += s[1] * w; a[4 * q + 2] += s[2] * w; a[4 * q + 3] += s[3] * w; }
            }
            if (k0 + 16 < 128) {
#pragma unroll
                for (int i = 0; i < 16; ++i) wv[i] = wn[i]; }
        }
#pragma unroll
        for (int b = 0; b < 16; ++b) red[(F.wave * 16 + b) * 64 + F.lane] = a[b];
        __syncthreads();
        for (int o = F.tid; o < 1024; o += NTHR) { const int b = o >> 6, jj = o & 63; float s = 0.f;
#pragma unroll
            for (int w = 0; w < 8; ++w) s += red[(w * 16 + b) * 64 + jj];
            mod[((size_t)ls * NB + b) * 3072 + j0 + jj] = s + args.in[3][(size_t)ls * 3072 + j0 + jj]; }
        __syncthreads();
    }
    if (F.bx == 0) {
        float* lbo = (float*)(F.ws + WS_LB); const float* lg = args.in[6];
        const int j = F.tid;
        const float l0 = lg[j], l1 = lg[512 + j], l2 = lg[1024 + j], l3 = lg[1536 + j];
        const float mx = fmaxf(fmaxf(l0, l1), fmaxf(l2, l3));
        const float e0 = expf(l0 - mx), e1 = expf(l1 - mx), e2 = expf(l2 - mx), e3 = expf(l3 - mx), inv = 1.0f / (e0 + e1 + e2 + e3);
        lbo[j] = 0.f; lbo[512 + j] = e1 * inv; lbo[1024 + j] = (e1 + e2) * inv; lbo[1536 + j] = (e1 + e2 + e3) * inv;
    }
}
__device__ __forceinline__ void h_store_i8(const f32x4 (&hv)[4], float am, signed char* dst, float* scl_out, int lane) {
#pragma unroll
    for (int o = 1; o < 64; o <<= 1) am = fmaxf(am, __shfl_xor(am, o));
    const float scl = fmaxf(am, 1e-30f) * (1.0f / 127.0f), inv = 1.0f / scl;
    unsigned* q8 = (unsigned*)dst;
#pragma unroll
    for (int jj = 0; jj < 4; ++jj) { unsigned pk = 0;
#pragma unroll
        for (int i = 0; i < 4; ++i) pk |= ((unsigned)(int)rintf(hv[jj][i] * inv) & 0xffu) << (8 * i);
        q8[64 * jj] = pk; }
    if (lane == 0) *scl_out = scl;
}
__device__ __forceinline__ void h0_phase(Frame& F, const Args& args) {
    PHASE_TID(F);
    const int gw = F.bx * NWAVES + F.wave, NGW = F.G * NWAVES;
    const float* mod = (const float*)(F.ws + WS_MOD); bf16* HB = (bf16*)(F.ws + WS_HB);
    for (int blk = gw; blk < M / 32; blk += NGW) {
        const int row0 = blk * 32, b = row0 / SEQ;
        const float* mb = mod + ((size_t)(0 * 2 + 0) * NB + b) * 3072;
        f32x4 sh[4], sc[4];
#pragma unroll
        for (int jj = 0; jj < 4; ++jj) { sh[jj] = *(const f32x4*)(mb + 4 * F.lane + 256 * jj); sc[jj] = *(const f32x4*)(mb + 1024 + 4 * F.lane + 256 * jj); }
        const float* xr0 = args.in[0] + (size_t)row0 * D + 4 * F.lane;
        f32x4 xa[4], xb[4];
#pragma unroll
        for (int jj = 0; jj < 4; ++jj) { xa[jj] = __builtin_nontemporal_load((const f32x4*)(xr0 + 256 * jj)); xb[jj] = __builtin_nontemporal_load((const f32x4*)(xr0 + D + 256 * jj)); }
        for (int r = 0; r < 32; r += 2) {
#pragma unroll
            for (int half = 0; half < 2; ++half) {
                f32x4 hv[4]; float am = 0.f;
#pragma unroll
                for (int jj = 0; jj < 4; ++jj) { const f32x4 v = half ? xb[jj] : xa[jj]; hv[jj] = v * (1.0f + sc[jj]) + sh[jj];
                    am = fmaxf(fmaxf(am, fmaxf(fabsf(hv[jj][0]), fabsf(hv[jj][1]))), fmaxf(fabsf(hv[jj][2]), fabsf(hv[jj][3]))); }
                if (r + 2 < 32) {
#pragma unroll
                    for (int jj = 0; jj < 4; ++jj) { const f32x4 t = __builtin_nontemporal_load((const f32x4*)(xr0 + (size_t)(r + 2 + half) * D + 256 * jj)); if (half) xb[jj] = t; else xa[jj] = t; }
                }
                h_store_i8(hv, am, (signed char*)HB + (size_t)(row0 + r + half) * D + 4 * F.lane, (float*)(F.ws + WS_HSC) + row0 + r + half, F.lane);
            }
        }
    }
}
template <int MODE, bool ROUTE, int H8>
__device__ __forceinline__ void ln_phase(Frame& F, const float* xsrc  , bool xin16  , bool xout16  , const bf16* Y, const float* gate_mod  , const float* lng, const float* lnb,
                                         const float* next_mod  , const float* wrouter, int jm) {
    PHASE_TID(F);
    _Float16* XH = (_Float16*)(F.ws + WS_XH);
    const int gw = F.bx * NWAVES + F.wave, NGW = F.G * NWAVES;
    bf16* HB = (bf16*)(F.ws + WS_HB);
    unsigned* route = (unsigned*)(F.ws + WS_ROUTE);
    LAS float* wr_l = (LAS float*)F.lds;
    LAS int* lcnt = (LAS int*)(F.lds + 32768);
    LAS int* llist = (LAS int*)(F.lds + 32768 + 256);
    if (ROUTE) {
        for (int i = F.tid; i < D * NE; i += NTHR) wr_l[i] = wrouter[i];
        if (F.tid < 16) lcnt[F.tid] = 0;
        __syncthreads();
    }
    f32x4 g4[4], b4[4];
#pragma unroll
    for (int jj = 0; jj < 4; ++jj) { g4[jj] = *(const f32x4*)(lng + 4 * F.lane + 256 * jj); b4[jj] = *(const f32x4*)(lnb + 4 * F.lane + 256 * jj); }
    for (int blk = gw; blk < M / 32; blk += NGW) {
        const int row0 = blk * 32, b = row0 / SEQ;
        f32x4 gt[4], nsh[4], nsc[4];
#pragma unroll
        for (int jj = 0; jj < 4; ++jj) { gt[jj] = *(const f32x4*)(gate_mod + (size_t)b * 3072 + 2048 + 4 * F.lane + 256 * jj);
            if (next_mod) { nsh[jj] = *(const f32x4*)(next_mod + (size_t)b * 3072 + 4 * F.lane + 256 * jj); nsc[jj] = *(const f32x4*)(next_mod + (size_t)b * 3072 + 1024 + 4 * F.lane + 256 * jj); }
            else { nsh[jj] = (f32x4){0.f, 0.f, 0.f, 0.f}; nsc[jj] = nsh[jj]; } }
        f32x4 xq[4]; u32x2 xhq[4], yq0[4], yq1[4];
#define LN_LOAD(rr) do { const int row_ = row0 + (rr); const float* xr_ = xsrc + (size_t)row_ * D + 4 * F.lane; const _Float16* xh_ = XH + (size_t)row_ * D + 4 * F.lane; \
            _Pragma("unroll") for (int jj = 0; jj < 4; ++jj) { \
                if (xin16) xhq[jj] = __builtin_nontemporal_load((const u32x2*)(xh_ + 256 * jj)); \
                else xq[jj] = __builtin_nontemporal_load((const f32x4*)(xr_ + 256 * jj)); \
                if (MODE == 0) yq0[jj] = *(const u32x2*)(Y + (size_t)row_ * D + 4 * F.lane + 256 * jj); \
                else { yq0[jj] = *(const u32x2*)(Y + (size_t)row_ * 2 * D + 4 * F.lane + 256 * jj); yq1[jj] = *(const u32x2*)(Y + (size_t)row_ * 2 * D + D + 4 * F.lane + 256 * jj); } } } while (0)
        LN_LOAD(0);
        for (int r = 0; r < 32; ++r) {
            const int row = row0 + r;
            f32x4 v[4]; float s = 0.f;
            float w0 = 1.f, w1 = 0.f;
            if (MODE == 1) { const unsigned* rt = route + (size_t)row * 4; w0 = __builtin_bit_cast(float, rt[1]); w1 = __builtin_bit_cast(float, rt[2]); }
#pragma unroll
            for (int jj = 0; jj < 4; ++jj) {
                f32x4 x = xq[jj];
                if (xin16) x = __builtin_convertvector(__builtin_bit_cast(f16x4_t, xhq[jj]), f32x4);
                f32x4 y;
                if (MODE == 0) { const u32x2 yw = yq0[jj]; y = (f32x4){bflo(yw.x), bfhi(yw.x), bflo(yw.y), bfhi(yw.y)}; }
                else { const u32x2 ya = yq0[jj], yb = yq1[jj];
                    y = (f32x4){bflo(ya.x), bfhi(ya.x), bflo(ya.y), bfhi(ya.y)} * w0 + (f32x4){bflo(yb.x), bfhi(yb.x), bflo(yb.y), bfhi(yb.y)} * w1; }
                v[jj] = x * ALPHA + gt[jj] * y;
                s += (v[jj][0] + v[jj][1]) + (v[jj][2] + v[jj][3]);
            }
            if (r + 1 < 32) LN_LOAD(r + 1);
            const float mean = wave_sum(s) * (1.f / D); float s2 = 0.f;
#pragma unroll
            for (int jj = 0; jj < 4; ++jj) { v[jj] = v[jj] - mean; s2 += (v[jj][0] * v[jj][0] + v[jj][1] * v[jj][1]) + (v[jj][2] * v[jj][2] + v[jj][3] * v[jj][3]); }
            const float rstd = 1.0f / sqrtf(wave_sum(s2) * (1.f / D) + LN_EPS);
            float* orow = F.out + (size_t)row * D + 4 * F.lane;
            unsigned long long* h8 = (unsigned long long*)(HB + (size_t)row * D + 4 * F.lane);
            float lg[NE];
#pragma unroll
            for (int e = 0; e < NE; ++e) lg[e] = 0.f;
            f32x4 hv[4];
#pragma unroll
            for (int jj = 0; jj < 4; ++jj) {
                const f32x4 xn = v[jj] * rstd * g4[jj] + b4[jj];
                if (xout16) __builtin_nontemporal_store(__builtin_bit_cast(u32x2, __builtin_convertvector(xn, f16x4_t)), (u32x2*)(XH + (size_t)row * D + 4 * F.lane + 256 * jj));
                else __builtin_nontemporal_store(xn, (f32x4*)(orow + 256 * jj));
                if (next_mod) {
                    const f32x4 h = xn * (1.0f + nsc[jj]) + nsh[jj];
                    hv[jj] = h;
                    if (H8 == 0) h8[64 * jj] = (unsigned long long)pk2(h[0], h[1]) | ((unsigned long long)pk2(h[2], h[3]) << 32);
                    if (ROUTE) {
#pragma unroll
                        for (int i = 0; i < 4; ++i) { const LAS f32x4* wp = (const LAS f32x4*)(wr_l + (4 * F.lane + 256 * jj + i) * 8); const f32x4 wa = wp[0], wb = wp[1];
                            lg[0] += h[i] * wa[0]; lg[1] += h[i] * wa[1]; lg[2] += h[i] * wa[2]; lg[3] += h[i] * wa[3]; lg[4] += h[i] * wb[0]; lg[5] += h[i] * wb[1]; lg[6] += h[i] * wb[2]; lg[7] += h[i] * wb[3]; }
                    }
                }
            }
            if (H8 == 2 && next_mod) {
                float am = 0.f;
#pragma unroll
                for (int jj = 0; jj < 4; ++jj) am = fmaxf(fmaxf(am, fmaxf(fabsf(hv[jj][0]), fabsf(hv[jj][1]))), fmaxf(fabsf(hv[jj][2]), fabsf(hv[jj][3])));
                h_store_i8(hv, am, (signed char*)HB + (size_t)row * D + 4 * F.lane, (float*)(F.ws + WS_HSC) + row, F.lane);
            }
            if (H8 == 1 && next_mod) {
                unsigned* q8 = (unsigned*)((signed char*)HB + (size_t)row * D + 4 * F.lane);
#pragma unroll
                for (int jj = 0; jj < 4; ++jj) { int p = pk_fp8(hv[jj][0] * H2_SCALE, hv[jj][1] * H2_SCALE, 0, false);
                    p = pk_fp8(hv[jj][2] * H2_SCALE, hv[jj][3] * H2_SCALE, p, true); q8[64 * jj] = (unsigned)p; }
            }
            if (ROUTE) {
#pragma unroll
                for (int e = 0; e < NE; ++e) lg[e] = wave_sum(lg[e]);
                int e0 = 0; float v0 = lg[0];
#pragma unroll
                for (int e = 1; e < NE; ++e) if (lg[e] > v0) { v0 = lg[e]; e0 = e; }
                int e1 = -1; float v1 = -3.0e38f;
#pragma unroll
                for (int e = 0; e < NE; ++e) if (e != e0 && lg[e] > v1) { v1 = lg[e]; e1 = e; }
                const float ex = __expf(v1 - v0), inv = 1.0f / (1.0f + ex);
                if (F.lane == 0) {
                    unsigned* rt = route + (size_t)row * 4; rt[0] = (unsigned)e0 | ((unsigned)e1 << 8); rt[1] = __builtin_bit_cast(unsigned, inv); rt[2] = __builtin_bit_cast(unsigned, ex * inv); rt[3] = 0u;
                    const int p0 = atomicAdd((int*)&lcnt[e0], 1); llist[e0 * 512 + p0] = row * 2;
                    const int p1 = atomicAdd((int*)&lcnt[e1], 1); llist[e1 * 512 + p1] = row * 2 + 1;
                }
            }
        }
    }
#undef LN_LOAD
    if (ROUTE) {
        __syncthreads();
        if (F.tid < NE) lcnt[8 + F.tid] = (int)__hip_atomic_fetch_add((unsigned*)(F.ctl + CW_CNT + (jm * 8 + F.tid) * 64), (unsigned)lcnt[F.tid], RLX_AGENT);
        __syncthreads();
        int* glist = (int*)(F.ws + WS_LIST);
#pragma unroll 1
        for (int e = 0; e < NE; ++e) { const int n = lcnt[e], base = lcnt[8 + e]; for (int i = F.tid; i < n; i += NTHR) glist[(size_t)e * M + base + i] = llist[e * 512 + i]; }
    }
}

constexpr int P64 = 144;
constexpr int P128 = 272;
__device__ __forceinline__ void hgrn_m1(Frame& F) {
    PHASE_TID(F);
    LAS unsigned char* KT = F.lds; LAS unsigned char* VT = F.lds + 18432; LAS float* Tl = (LAS float*)(F.lds + 36864); LAS float* Dl = (LAS float*)(F.lds + 38912);
    const bf16* PROJ = (const bf16*)(F.ws + WS_PROJ);
    bf16* RS = (bf16*)(F.ws + WS_RS); float* RD = (float*)(F.ws + WS_RD);
    const int k = F.tid & 127, i = F.tid >> 7;
    const int r32 = F.lane & 31, hi = F.lane >> 5;
    unsigned short gr[16], vr[16];
#define M1_LOAD(un) do { const int bh_ = (un) >> 6, c_ = (un) & 63; const bf16* prow_ = PROJ + ((size_t)(bh_ >> 2) * SEQ + 64 * c_ + 16 * i) * NPROJ + 128 * (bh_ & 3) + k; \
        _Pragma("unroll") for (int j = 0; j < 16; ++j) { gr[j] = prow_[(size_t)j * NPROJ + C_HG]; vr[j] = prow_[(size_t)j * NPROJ + C_HV]; } } while (0)
    if (F.bx < 256) M1_LOAD(16 * F.bx);
    for (int rg = F.bx; rg < 256; rg += F.G) {
        const int kt = F.wave >> 1, vt0 = 2 * (F.wave & 1);
        f32x16 st[2];
#pragma unroll
        for (int x = 0; x < 2; ++x)
#pragma unroll
            for (int r = 0; r < 16; ++r) st[x][r] = 0.f;
        float dpre = 1.0f;
#pragma unroll 1
        for (int cc = 0; cc < 16; ++cc) {
            const int unit = 16 * rg + cc;
            float g[16];
#pragma unroll
            for (int j = 0; j < 16; ++j) g[j] = bf2f(gr[j]);
            float cs[16]; float run = 0.f;
#pragma unroll
            for (int j = 0; j < 16; ++j) { run += g[j]; cs[j] = run; }
            Tl[i * 128 + k] = run;
            __syncthreads();
            const float T0 = Tl[k], T1 = Tl[128 + k], T2 = Tl[256 + k], T3 = Tl[384 + k];
            const float after = (i == 0) ? (T1 + T2 + T3) : (i == 1) ? (T2 + T3) : (i == 2) ? T3 : 0.f;
            const float Gi = __expf(after);
            if (i == 0) { const float dc = __expf(T0 + T1 + T2 + T3); dpre *= dc; Dl[k] = dc; }
            unsigned kw[8], vw[8];
            float fj[16], e2a[16];
#pragma unroll
            for (int j = 0; j < 16; ++j) fj[j] = __expf(g[j]);
            { float p = Gi;
#pragma unroll
              for (int j = 15; j >= 0; --j) { e2a[j] = p; p *= fj[j]; } }
#pragma unroll
            for (int j = 0; j < 16; j += 2) {
                const float ka = (1.0f - fj[j]) * e2a[j], kb2 = (1.0f - fj[j + 1]) * e2a[j + 1];
                kw[j >> 1] = pk2(ka, kb2); vw[j >> 1] = (unsigned)vr[j] | ((unsigned)vr[j + 1] << 16);
            }
            *(LAS u32x4*)(KT + k * P64 + 32 * i) = (u32x4){kw[0], kw[1], kw[2], kw[3]}; *(LAS u32x4*)(KT + k * P64 + 32 * i + 16) = (u32x4){kw[4], kw[5], kw[6], kw[7]};
            *(LAS u32x4*)(VT + k * P64 + 32 * i) = (u32x4){vw[0], vw[1], vw[2], vw[3]}; *(LAS u32x4*)(VT + k * P64 + 32 * i + 16) = (u32x4){vw[4], vw[5], vw[6], vw[7]};
            { const int nu = (cc < 15) ? unit + 1 : 16 * (rg + F.G); if (nu < 4096) M1_LOAD(nu); }
            __syncthreads();
#pragma unroll
            for (int g4 = 0; g4 < 4; ++g4) { const f32x4 d4 = *(const LAS f32x4*)(Dl + 32 * kt + 8 * g4 + 4 * hi);
#pragma unroll
                for (int x = 0; x < 2; ++x)
#pragma unroll
                    for (int j = 0; j < 4; ++j) st[x][4 * g4 + j] *= d4[j]; }
#pragma unroll
            for (int s2 = 0; s2 < 4; ++s2) {
                const bf16x8 a = *(const LAS bf16x8*)(KT + (32 * kt + r32) * P64 + (8 * hi + 16 * s2) * 2);
#pragma unroll
                for (int x = 0; x < 2; ++x) { const bf16x8 bb = *(const LAS bf16x8*)(VT + (32 * (vt0 + x) + r32) * P64 + (8 * hi + 16 * s2) * 2);
                    st[x] = __builtin_amdgcn_mfma_f32_32x32x16_bf16(a, bb, st[x], 0, 0, 0); }
            }
            __syncthreads();
        }
#pragma unroll
        for (int x = 0; x < 2; ++x)
#pragma unroll
            for (int g4 = 0; g4 < 4; ++g4) { u32x2 w; w.x = cvt_pk_bf16(st[x][4 * g4], st[x][4 * g4 + 1]); w.y = cvt_pk_bf16(st[x][4 * g4 + 2], st[x][4 * g4 + 3]);
                *(u32x2*)(RS + (size_t)rg * 16384 + (size_t)(32 * (vt0 + x) + r32) * 128 + 32 * kt + 8 * g4 + 4 * hi) = w; }
        if (i == 0) RD[(size_t)rg * 128 + k] = dpre;
    }
}
#undef M1_LOAD
__device__ __forceinline__ void hgrn_m2(Frame& F) {
    PHASE_TID(F);
    bf16* RS = (bf16*)(F.ws + WS_RS); const float* RD = (const float*)(F.ws + WS_RD);
    for (int gid = F.bx * NTHR + F.tid; gid < 64 * 2048; gid += F.G * NTHR) {
        const int bh = gid >> 11, e0 = (gid & 2047) * 8, k0 = e0 & 127;
        float S[8];
        float z0 = 0.f; asm volatile("" : "+v"(z0));
#pragma unroll
        for (int j = 0; j < 8; ++j) S[j] = z0;
        bf16* p = RS + (size_t)bh * 4 * 16384 + e0; const float* dp = RD + (size_t)bh * 4 * 128 + k0;
#pragma unroll
        for (int c = 0; c < 4; ++c) {
            const u32x4 u = *(const u32x4*)(p + (size_t)c * 16384);
            const f32x4 d0 = *(const f32x4*)(dp + c * 128), d1 = *(const f32x4*)(dp + c * 128 + 4);
            u32x4 o; o.x = pk2(S[0], S[1]); o.y = pk2(S[2], S[3]); o.z = pk2(S[4], S[5]); o.w = pk2(S[6], S[7]);
            *(u32x4*)(p + (size_t)c * 16384) = o;
            S[0] = d0[0] * S[0] + bflo(u.x); S[1] = d0[1] * S[1] + bfhi(u.x); S[2] = d0[2] * S[2] + bflo(u.y); S[3] = d0[3] * S[3] + bfhi(u.y);
            S[4] = d1[0] * S[4] + bflo(u.z); S[5] = d1[1] * S[5] + bfhi(u.z); S[6] = d1[2] * S[6] + bflo(u.w); S[7] = d1[3] * S[7] + bfhi(u.w);
        }
    }
}
__device__ __forceinline__ void hgrn_m3(Frame& F) {
    PHASE_TID(F);
    LAS unsigned char* QT = F.lds; LAS unsigned char* QH = F.lds + 17408; LAS unsigned char* KH = F.lds + 60928; LAS unsigned char* VT = F.lds + 78336;
    LAS unsigned char* ST = F.lds + 96768; LAS float* Tl = (LAS float*)(F.lds + 131584); LAS float* SS = (LAS float*)(F.lds + 133632);
    LAS float* Dl = (LAS float*)(F.lds + 134144); LAS unsigned char* KT = F.lds + 134656;
    const bf16* PROJ = (const bf16*)(F.ws + WS_PROJ); bf16* HB = (bf16*)(F.ws + WS_HB);
    const bf16* RS = (const bf16*)(F.ws + WS_RS);
    const int r32 = F.lane & 31, hi5 = F.lane >> 5, kt = F.wave >> 1, vt0 = 2 * (F.wave & 1);
    const int k = F.tid & 127, i = F.tid >> 7;
    const int c16 = F.lane & 15, g = F.lane >> 4;
    const int wi = F.wave & 3, vh = F.wave >> 2;
    unsigned short qr[16], gr[16], vq[16];
#define M3_LOAD(un) do { const int bh_ = (un) >> 6, c_ = (un) & 63; const bf16* prow_ = PROJ + ((size_t)(bh_ >> 2) * SEQ + 64 * c_ + 16 * i) * NPROJ + 128 * (bh_ & 3) + k; \
        _Pragma("unroll") for (int j = 0; j < 16; ++j) { qr[j] = prow_[(size_t)j * NPROJ + C_HQ]; gr[j] = prow_[(size_t)j * NPROJ + C_HG]; vq[j] = prow_[(size_t)j * NPROJ + C_HV]; } } while (0)
    if (F.bx < 256) M3_LOAD(16 * F.bx);
    for (int rg = F.bx; rg < 256; rg += F.G) {
      f32x16 st[2];
#pragma unroll
      for (int x = 0; x < 2; ++x)
#pragma unroll
          for (int g4 = 0; g4 < 4; ++g4) { const u32x2 w = *(const u32x2*)(RS + (size_t)rg * 16384 + (size_t)(32 * (vt0 + x) + r32) * 128 + 32 * kt + 8 * g4 + 4 * hi5);
              st[x][4 * g4] = bflo(w.x); st[x][4 * g4 + 1] = bfhi(w.x); st[x][4 * g4 + 2] = bflo(w.y); st[x][4 * g4 + 3] = bfhi(w.y); }
#pragma unroll 1
      for (int cc = 0; cc < 16; ++cc) {
        const int unit = 16 * rg + cc;
        const int bh = unit >> 6, c = unit & 63, b = bh >> 2, h = bh & 3;
        const size_t t0 = (size_t)b * SEQ + 64 * c;
        float q[16], gg[16]; unsigned short vr[16];
#pragma unroll
        for (int j = 0; j < 16; ++j) { q[j] = bf2f(qr[j]); gg[j] = bf2f(gr[j]); vr[j] = vq[j]; }
        float cs[16]; float run = 0.f;
#pragma unroll
        for (int j = 0; j < 16; ++j) { run += gg[j]; cs[j] = run; }
        Tl[i * 128 + k] = run;
        __syncthreads();
        const float T0 = Tl[k], T1 = Tl[128 + k], T2 = Tl[256 + k], T3 = Tl[384 + k];
        const float Bi = (i == 0) ? 0.f : (i == 1) ? T0 : (i == 2) ? (T0 + T1) : (T0 + T1 + T2);
        const float Gi = __expf((i == 0) ? (T1 + T2 + T3) : (i == 1) ? (T2 + T3) : (i == 2) ? T3 : 0.f);
        if (i == 0) Dl[k] = __expf(T0 + T1 + T2 + T3);
        const float eB = __expf(Bi);
        float Fq[4];
        Fq[0] = (i == 0) ? __expf(fminf(-run, 80.f)) : (i == 1) ? 1.0f : (i == 2) ? __expf(T1) : __expf(T1 + T2);
        Fq[1] = (i == 1) ? __expf(fminf(-run, 80.f)) : (i == 2) ? 1.0f : __expf(T2);
        Fq[2] = (i == 2) ? __expf(fminf(-run, 80.f)) : 1.0f;
        Fq[3] = __expf(fminf(-run, 80.f));
        const int blk0 = (i * (i + 1)) >> 1;
        unsigned vw[8], kw[8];
        float fj[16], e1a[16], e2a[16];
#pragma unroll
        for (int j = 0; j < 16; ++j) fj[j] = __expf(gg[j]);
        { float p = 1.0f;
#pragma unroll
          for (int j = 0; j < 16; ++j) { p *= fj[j]; e1a[j] = p; }
          p = 1.0f;
#pragma unroll
          for (int j = 15; j >= 0; --j) { e2a[j] = p; p *= fj[j]; } }
#pragma unroll
        for (int j = 0; j < 16; ++j) {
            const float e1 = e1a[j], e2 = e2a[j], kk = 1.0f - fj[j];
            const float qe = q[j] * e1;
            *(LAS unsigned short*)(QT + (16 * i + j) * P128 + k * 2) = (unsigned short)f2bf(qe * eB);
            *(LAS unsigned short*)(KH + (16 * i + j) * P128 + k * 2) = (unsigned short)f2bf(kk * e2);
#pragma unroll
            for (int jj = 0; jj < 4; ++jj) if (jj <= i) *(LAS unsigned short*)(QH + (blk0 + jj) * (16 * P128) + j * P128 + k * 2) = (unsigned short)f2bf(qe * Fq[jj]);
            if (j & 1) { vw[j >> 1] = (unsigned)vr[j - 1] | ((unsigned)vr[j] << 16); kw[j >> 1] = pk2((1.0f - fj[j - 1]) * e2a[j - 1] * Gi, kk * e2 * Gi); }
        }
        *(LAS u32x4*)(KT + k * P64 + 32 * i) = (u32x4){kw[0], kw[1], kw[2], kw[3]}; *(LAS u32x4*)(KT + k * P64 + 32 * i + 16) = (u32x4){kw[4], kw[5], kw[6], kw[7]};
        *(LAS u32x4*)(VT + k * P64 + 32 * i) = (u32x4){vw[0], vw[1], vw[2], vw[3]}; *(LAS u32x4*)(VT + k * P64 + 32 * i + 16) = (u32x4){vw[4], vw[5], vw[6], vw[7]};
#pragma unroll
        for (int x = 0; x < 2; ++x)
#pragma unroll
            for (int g4 = 0; g4 < 4; ++g4) { u32x2 w; w.x = cvt_pk_bf16(st[x][4 * g4], st[x][4 * g4 + 1]); w.y = cvt_pk_bf16(st[x][4 * g4 + 2], st[x][4 * g4 + 3]);
                *(LAS u32x2*)(ST + (32 * (vt0 + x) + r32) * P128 + (32 * kt + 8 * g4 + 4 * hi5) * 2) = w; }
        { const int nu = (cc < 15) ? unit + 1 : 16 * (rg + F.G); if (nu < 4096) M3_LOAD(nu); }
        __syncthreads();
#pragma unroll
        for (int g4 = 0; g4 < 4; ++g4) { const f32x4 d4 = *(const LAS f32x4*)(Dl + 32 * kt + 8 * g4 + 4 * hi5);
#pragma unroll
            for (int x = 0; x < 2; ++x)
#pragma unroll
                for (int j = 0; j < 4; ++j) st[x][4 * g4 + j] *= d4[j]; }
#pragma unroll
        for (int s2 = 0; s2 < 4; ++s2) {
            const bf16x8 a = *(const LAS bf16x8*)(KT + (32 * kt + r32) * P64 + (8 * hi5 + 16 * s2) * 2);
#pragma unroll
            for (int x = 0; x < 2; ++x) { const bf16x8 bb = *(const LAS bf16x8*)(VT + (32 * (vt0 + x) + r32) * P64 + (8 * hi5 + 16 * s2) * 2);
                st[x] = __builtin_amdgcn_mfma_f32_32x32x16_bf16(a, bb, st[x], 0, 0, 0); }
        }
        unsigned short gv[4][4];
#pragma unroll
        for (int vt = 0; vt < 4; ++vt)
#pragma unroll
            for (int r = 0; r < 4; ++r) gv[vt][r] = PROJ[(t0 + 16 * wi + 4 * g + r) * NPROJ + C_HGATE + 128 * h + 64 * vh + 16 * vt + c16];
        unsigned pk[4][2];
#pragma unroll
        for (int jj = 0; jj < 4; ++jj) { pk[jj][0] = 0u; pk[jj][1] = 0u; }
#pragma unroll
        for (int jj = 0; jj < 4; ++jj) {
            if (jj <= wi) {
                f32x4 sc = (f32x4){0.f, 0.f, 0.f, 0.f};
                const int blk = ((wi * (wi + 1)) >> 1) + jj;
#pragma unroll
                for (int ks = 0; ks < 4; ++ks) {
                    const bf16x8 a = *(const LAS bf16x8*)(KH + (16 * jj + c16) * P128 + (8 * g + 32 * ks) * 2);
                    const bf16x8 bq = *(const LAS bf16x8*)(QH + blk * (16 * P128) + c16 * P128 + (8 * g + 32 * ks) * 2);
                    sc = __builtin_amdgcn_mfma_f32_16x16x32_bf16(a, bq, sc, 0, 0, 0);
                }
                if (jj == wi) {
#pragma unroll
                    for (int r = 0; r < 4; ++r) if (4 * g + r > c16) sc[r] = 0.f;
                }
                pk[jj][0] = cvt_pk_bf16(sc[0], sc[1]); pk[jj][1] = cvt_pk_bf16(sc[2], sc[3]);
            }
        }
        f32x4 o[4];
#pragma unroll
        for (int vt = 0; vt < 4; ++vt) {
            o[vt] = (f32x4){0.f, 0.f, 0.f, 0.f};
            const int v = 64 * vh + 16 * vt + c16;
            { const u32x4 aw = (u32x4){pk[0][0], pk[0][1], pk[1][0], pk[1][1]};
              const u32x2 b0 = *(const LAS u32x2*)(VT + v * P64 + (0 + 4 * g) * 2), b1 = *(const LAS u32x2*)(VT + v * P64 + (16 + 4 * g) * 2);
              const u32x4 bw = (u32x4){b0.x, b0.y, b1.x, b1.y};
              o[vt] = __builtin_amdgcn_mfma_f32_16x16x32_bf16(__builtin_bit_cast(bf16x8, aw), __builtin_bit_cast(bf16x8, bw), o[vt], 0, 0, 0); }
            if (wi >= 2) {
              const u32x4 aw = (u32x4){pk[2][0], pk[2][1], pk[3][0], pk[3][1]};
              const u32x2 b0 = *(const LAS u32x2*)(VT + v * P64 + (32 + 4 * g) * 2), b1 = *(const LAS u32x2*)(VT + v * P64 + (48 + 4 * g) * 2);
              const u32x4 bw = (u32x4){b0.x, b0.y, b1.x, b1.y};
              o[vt] = __builtin_amdgcn_mfma_f32_16x16x32_bf16(__builtin_bit_cast(bf16x8, aw), __builtin_bit_cast(bf16x8, bw), o[vt], 0, 0, 0); }
#pragma unroll
            for (int ks = 0; ks < 4; ++ks) {
                const bf16x8 a = *(const LAS bf16x8*)(QT + (16 * wi + c16) * P128 + (8 * g + 32 * ks) * 2);
                const bf16x8 bs = *(const LAS bf16x8*)(ST + v * P128 + (8 * g + 32 * ks) * 2);
                o[vt] = __builtin_amdgcn_mfma_f32_16x16x32_bf16(a, bs, o[vt], 0, 0, 0);
            }
        }
        float ssq[4];
#pragma unroll
        for (int r = 0; r < 4; ++r) { float s = 0.f;
#pragma unroll
            for (int vt = 0; vt < 4; ++vt) s += o[vt][r] * o[vt][r];
            s += __shfl_xor(s, 1); s += __shfl_xor(s, 2); s += __shfl_xor(s, 4); s += __shfl_xor(s, 8); ssq[r] = s; }
        if (c16 == 0) {
#pragma unroll
            for (int r = 0; r < 4; ++r) SS[vh * 64 + 16 * wi + 4 * g + r] = ssq[r];
        }
        __syncthreads();
#pragma unroll
        for (int r = 0; r < 4; ++r) {
            const int t = 16 * wi + 4 * g + r;
            const float tot = SS[t] + SS[64 + t];
            const float rstd = 1.0f / sqrtf(tot * (1.0f / 128.0f) + RMS_EPS);
#pragma unroll
            for (int vt = 0; vt < 4; ++vt) HB[(t0 + t) * D + 128 * h + 64 * vh + 16 * vt + c16] = (unsigned short)f2bf(o[vt][r] * rstd * bf2f(gv[vt][r]));
        }
        __syncthreads();
      }
    }
}

#undef M3_LOAD
__device__ __forceinline__ void sb_attn(Frame& F) {
    PHASE_TID(F);
    const bf16* PROJ = (const bf16*)(F.ws + WS_PROJ); bf16* HB = (bf16*)(F.ws + WS_HB);
    LAS unsigned char* Vb = F.lds + 40960 + F.wave * 4608;
    LAS unsigned char* Qs = F.lds + 77824 + F.wave * 8192;
    const int lane = F.lane, r32 = F.lane & 31, hi = F.lane >> 5;
    const int gw = F.bx * NWAVES + F.wave, NGW = F.G * NWAVES;
    for (int u = gw; u < NB * 8 * 64; u += NGW) {
        const int b = u >> 9, h = (u >> 6) & 7, qL = 2 * (u & 63), qU = qL + 1;
        const size_t tok0 = (size_t)b * SEQ;
        { const bf16* Qp = PROJ + (tok0 + 32 * qL + r32) * NPROJ + C_SQ + 64 * h + 8 * hi;
          bf16x8 qt[8];
#pragma unroll
          for (int ds = 0; ds < 4; ++ds) { qt[ds] = *(const bf16x8*)(Qp + 16 * ds); qt[4 + ds] = *(const bf16x8*)(Qp + (size_t)32 * NPROJ + 16 * ds); }
#pragma unroll
          for (int i = 0; i < 8; ++i) *(LAS bf16x8*)(Qs + (i * 64 + lane) * 16) = qt[i]; }
        f32x16 oL[2], oU[2];
#pragma unroll
        for (int x = 0; x < 2; ++x)
#pragma unroll
            for (int r = 0; r < 16; ++r) { oL[x][r] = 0.f; oU[x][r] = 0.f; }
        float CL = 1.0f, CU = 1.0f;
        bool doneL = false, doneU = false;
        bf16x8 kf[4]; u32x4 vreg[4];
        { const bf16* Kp = PROJ + (tok0 + 32 * qU + r32) * NPROJ + C_SK + 64 * h + 8 * hi;
#pragma unroll
          for (int ds = 0; ds < 4; ++ds) kf[ds] = *(const bf16x8*)(Kp + 16 * ds);
#pragma unroll
          for (int n = 0; n < 4; ++n) { const int idx = lane + 64 * n; vreg[n] = *(const u32x4*)(PROJ + (tok0 + 32 * qU + (idx >> 3)) * NPROJ + C_SV + 64 * h + 8 * (idx & 7)); } }
        auto scores = [&](int up) __attribute__((always_inline)) -> f32x16 {
            f32x16 s;
#pragma unroll
            for (int r = 0; r < 16; ++r) s[r] = 0.f;
#pragma unroll
            for (int ds = 0; ds < 4; ++ds) { const bf16x8 qf = *(const LAS bf16x8*)(Qs + ((4 * up + ds) * 64 + lane) * 16); s = __builtin_amdgcn_mfma_f32_32x32x16_bf16(kf[ds], qf, s, 0, 0, 0); }
            return s;
        };
        auto weigh = [&](f32x16 s, f32x16 (&o)[2], float& C, bool diag) __attribute__((always_inline)) {
            if (diag) {
#pragma unroll
                for (int r = 0; r < 16; ++r) { const int key = (r & 3) + 8 * (r >> 2) + 4 * hi; s[r] = (key < r32) ? s[r] : -1e30f; }
            }
            float rm[16], bt[16];
#pragma unroll
            for (int r = 0; r < 16; ++r) {
                const float q1 = fast_rcp(1.0f + __builtin_amdgcn_exp2f(s[r]));
                rm[r] = q1;
                bt[r] = 1.0f - q1;
            }
            float Gs[4], Gp[4];
#pragma unroll
            for (int g4 = 0; g4 < 4; ++g4) { Gs[g4] = (rm[4 * g4] * rm[4 * g4 + 1]) * (rm[4 * g4 + 2] * rm[4 * g4 + 3]);
                const unsigned own = __builtin_bit_cast(unsigned, Gs[g4]);
                const u32x2 sw = __builtin_amdgcn_permlane32_swap(own, own, false, false);
                const unsigned r0 = sw.x, r1 = sw.y;
                Gp[g4] = __builtin_bit_cast(float, (r0 == own) ? r1 : r0); }
            float run = C;
            float a[16];
#pragma unroll
            for (int g4 = 3; g4 >= 0; --g4) {
                float sfx = run * (hi == 0 ? Gp[g4] : 1.0f);
                a[4 * g4 + 3] = bt[4 * g4 + 3] * sfx; sfx *= rm[4 * g4 + 3];
                a[4 * g4 + 2] = bt[4 * g4 + 2] * sfx; sfx *= rm[4 * g4 + 2];
                a[4 * g4 + 1] = bt[4 * g4 + 1] * sfx; sfx *= rm[4 * g4 + 1];
                a[4 * g4 + 0] = bt[4 * g4 + 0] * sfx;
                run *= Gs[g4] * Gp[g4];
            }
            C = run;
#pragma unroll
            for (int s2 = 0; s2 < 2; ++s2) {
                u32x4 pw; pw.x = cvt_pk_bf16(a[8 * s2 + 0], a[8 * s2 + 1]); pw.y = cvt_pk_bf16(a[8 * s2 + 2], a[8 * s2 + 3]); pw.z = cvt_pk_bf16(a[8 * s2 + 4], a[8 * s2 + 5]); pw.w = cvt_pk_bf16(a[8 * s2 + 6], a[8 * s2 + 7]);
                const bf16x8 pf = __builtin_bit_cast(bf16x8, pw);
#pragma unroll
                for (int dt = 0; dt < 2; ++dt) {
                    const int dcol = 32 * dt + 16 * ((lane >> 4) & 1) + 4 * (lane & 3);
                    const int krow = 16 * s2 + 4 * hi + ((lane & 15) >> 2);
                    const s16x4 t0v = __builtin_bit_cast(s16x4, __builtin_amdgcn_ds_read_tr16_b64_v4i16((LAS s16x4*)(Vb + krow * P64 + dcol * 2)));
                    const s16x4 t1v = __builtin_bit_cast(s16x4, __builtin_amdgcn_ds_read_tr16_b64_v4i16((LAS s16x4*)(Vb + (krow + 8) * P64 + dcol * 2)));
                    const bf16x8 vf = (bf16x8){t0v[0], t0v[1], t0v[2], t0v[3], t1v[0], t1v[1], t1v[2], t1v[3]};
                    o[dt] = __builtin_amdgcn_mfma_f32_32x32x16_bf16(vf, pf, o[dt], 0, 0, 0);
                }
            }
        };
        for (int kb = qU; kb >= 0; --kb) {
            const bool actU = !doneU, actL = (kb <= qL) && !doneL;
#pragma unroll
            for (int n = 0; n < 4; ++n) { const int idx = lane + 64 * n; *(LAS u32x4*)(Vb + (idx >> 3) * P64 + (idx & 7) * 16) = vreg[n]; }
            if (actU) { const f32x16 sU = scores(1); weigh(sU, oU, CU, kb == qU); doneU = __all(CU < 0x1p-120f); }
            f32x16 sL;
            if (actL) sL = scores(0);
            if (kb > 0) {
                const bf16* Kp = PROJ + (tok0 + 32 * (kb - 1) + r32) * NPROJ + C_SK + 64 * h + 8 * hi;
#pragma unroll
                for (int ds = 0; ds < 4; ++ds) kf[ds] = *(const bf16x8*)(Kp + 16 * ds);
#pragma unroll
                for (int n = 0; n < 4; ++n) { const int idx = lane + 64 * n; vreg[n] = *(const u32x4*)(PROJ + (tok0 + 32 * (kb - 1) + (idx >> 3)) * NPROJ + C_SV + 64 * h + 8 * (idx & 7)); }
            }
            if (actL) { weigh(sL, oL, CL, kb == qL); doneL = __all(CL < 0x1p-120f); }
            if (doneU && doneL) break;
        }
        bf16* orow = HB + (tok0 + 32 * qL + r32) * D + 512 + 64 * h + (hi ? 8 : 0);
        auto store_o = [&](const f32x16 (&o)[2], bf16* rowp) __attribute__((always_inline)) {
#pragma unroll
            for (int dt = 0; dt < 2; ++dt)
#pragma unroll
                for (int g4 = 0; g4 < 4; g4 += 2) {
                    unsigned ax = cvt_pk_bf16(o[dt][4 * g4], o[dt][4 * g4 + 1]), ay = cvt_pk_bf16(o[dt][4 * g4 + 2], o[dt][4 * g4 + 3]);
                    unsigned bx = cvt_pk_bf16(o[dt][4 * g4 + 4], o[dt][4 * g4 + 5]), by = cvt_pk_bf16(o[dt][4 * g4 + 6], o[dt][4 * g4 + 7]);
                    const u32x2 rx = __builtin_amdgcn_permlane32_swap(ax, bx, false, false); ax = rx.x; bx = rx.y;
                    const u32x2 ry = __builtin_amdgcn_permlane32_swap(ay, by, false, false); ay = ry.x; by = ry.y;
                    *(u32x4*)(rowp + 32 * dt + 8 * g4) = (u32x4){ax, ay, bx, by}; }
        };
        store_o(oL, orow); store_o(oU, orow + (size_t)32 * D);
    }
}

constexpr int PH_PER_LAYER = 13, N_PHASES = 2 + DEPTH * PH_PER_LAYER;
__global__ void __launch_bounds__(NTHR, 2) fwd_kernel(Args args) {
    extern __shared__ __attribute__((aligned(16))) unsigned char lds_raw[];
    Frame F;
    F.lds = (LAS unsigned char*)lds_raw;
    F.tid = threadIdx.x; F.lane = F.tid & 63; F.wave = __builtin_amdgcn_readfirstlane(F.tid >> 6);
    F.G = gridDim.x; F.bx = blockIdx.x;
    F.ws = args.ws; F.ws0 = args.ws; F.ctl = (gu32*)(args.ws + WS_CTL); F.out = args.out;
    volatile LAS unsigned* MISC = (volatile LAS unsigned*)(F.lds + MISC_OFF);
    if (F.tid < 64) MISC[F.tid] = 0u;
    __syncthreads();
    XcdBarrier bar; bar.bar = (unsigned*)(F.ctl + CW_BAR); bar.x = 0; bar.st = nullptr;
    if (!MK_PER_PHASE_LAUNCH) bar = xcd_barrier_post((unsigned*)(F.ctl + CW_BAR), MISC + 8);
    const int lo = args.ph_lo, hi = args.ph_hi;
#define IN(k) (lo <= (k) && (k) < hi)
#define SEAM(k) do { if (IN(k) && IN((k) + 1)) xcd_barrier(bar); } while (0)
    const float* modp = (const float*)(F.ws + WS_MOD);
    const float* lbp = (const float*)(F.ws + WS_LB);
    static_assert((DEPTH - 1) & 1, "the last layer must be a MoE layer: its LayerNorm overwrites each row's pair outputs in d_out with the row's f32 result (same 4 KiB)");
    bf16* HB = (bf16*)(F.ws + WS_HB); bf16* PROJ = (bf16*)(F.ws + WS_PROJ); bf16* YP = (bf16*)F.out;

    if (IN(0)) { pre_phase(F, args); win_absmax_all(F, args); conv_layer(F, args, 0); }
    SEAM(0);
    if (IN(1)) { h0_phase(F, args); conv_win(F, args, 0); }
    SEAM(1);

#pragma unroll 1
    for (int layer = 0; layer < DEPTH; ++layer) {
        const int pb = 2 + layer * PH_PER_LAYER;
        const int moe = layer & 1, jm = layer >> 1;
        if (IN(pb + 0)) {
            gm::PlainPolicy P; P.o.init(M / 256, NPROJ / 256, F.G, F.bx); P.Bt = (const bf16*)(F.ws + WS_WIN);
            gm::EpiInproj8 E{PROJ, lbp + layer * 512, args.in[7] + layer * 512, (const float*)(F.ws + WS_HSC), (const float*)(F.ctl + CW_WMAX + layer * NPROJ)};
            gm::gemm_phase<false, gm::EpiInproj8, gm::PlainPolicy, 1>(F.lds, HB, D / 2, P, E);
        }
        SEAM(pb + 0);
        if (IN(pb + 1)) { hgrn_m1(F); sb_attn(F); }
        SEAM(pb + 1);
        if (IN(pb + 2)) hgrn_m2(F);
        SEAM(pb + 2);
        if (IN(pb + 3)) hgrn_m3(F);
        SEAM(pb + 3);
        if (IN(pb + 4)) {
            gm::PlainPolicy P; P.o.init(M / 256, D / 256, F.G, F.bx); P.Bt = (const bf16*)(F.ws + WS_WOUT);
            gm::EpiPlain E{PROJ, D};
            gm::gemm_phase<false, gm::EpiPlain, gm::PlainPolicy>(F.lds, HB, D, P, E);
        }
        SEAM(pb + 4);
        if (IN(pb + 5)) {
            const float* xsrc = args.in[0]; const bool xin16 = layer != 0;
            const float* gm_ = modp + (size_t)(layer * 2 + 0) * NB * 3072; const float* nm = modp + (size_t)(layer * 2 + 1) * NB * 3072;
            if (moe) ln_phase<0, true, 1>(F, xsrc, xin16, true, PROJ, gm_, args.in[15] + (size_t)(layer * 2 + 0) * D, args.in[16] + (size_t)(layer * 2 + 0) * D, nm, args.in[11] + (size_t)jm * D * NE, jm);
            else ln_phase<0, false, 1>(F, xsrc, xin16, true, PROJ, gm_, args.in[15] + (size_t)(layer * 2 + 0) * D, args.in[16] + (size_t)(layer * 2 + 0) * D, nm, nullptr, 0);
        }
        SEAM(pb + 5);
        const int npass = 1;
#pragma unroll 1
        for (int pass = 0; pass < npass; ++pass) {
            gm::FfnPolicy P;
            P.moe = moe; P.list = (const int*)(F.ws + WS_LIST); P.tile0 = pass * 256; P.tab = (LAS const int*)(F.lds + gm::TILE_TAB_OFF);
            int ntiles = 256;
            if (moe) {
                int tot = 0;
#pragma unroll
                for (int e = 0; e < NE; ++e) { const int c = (int)__hip_atomic_load((unsigned*)(F.ctl + CW_CNT + (jm * 8 + e) * 64), RLX_AGENT); tot += (c + 255) >> 8; }
                ntiles = __builtin_amdgcn_readfirstlane(tot);
                __syncthreads();
                for (int T = opaque_tid(); T < ntiles; T += NTHR) {
                    int acc_t = 0, me = 0, mpe = 0, mc = 0;
#pragma unroll
                    for (int e = 0; e < NE; ++e) { const int c = (int)__hip_atomic_load((unsigned*)(F.ctl + CW_CNT + (jm * 8 + e) * 64), RLX_AGENT);
                        if (acc_t <= T) { me = e; mpe = acc_t; mc = c; } acc_t += (c + 255) >> 8; }
                    const int aux = (T - mpe) * 256; const int left = mc - aux; const int cnt = left < 256 ? left : 256;
                    ((LAS int*)(F.lds + gm::TILE_TAB_OFF))[2 * T] = me | (cnt << 4); ((LAS int*)(F.lds + gm::TILE_TAB_OFF))[2 * T + 1] = aux;
                }
                __syncthreads();
            }
            const int nM = ntiles;
            const int ff = moe ? DFFE : DFF;
            if (IN(pb + 6 + 2 * pass)) {
                P.o.init(nM, ff / 128, F.G, F.bx); P.W = (const bf16*)(F.ws + WS_WGU); P.wstride = (size_t)DFFE * D; P.gatherA = 1;
                gm::EpiGU8 E{(unsigned char*)PROJ, ff};
                gm::gemm_phase<true, gm::EpiGU8, gm::FfnPolicy, 2>(F.lds, HB, D / 2, P, E);
            }
            SEAM(pb + 6 + 2 * pass);
            if (IN(pb + 7 + 2 * pass)) {
                P.o.init(nM, D / 256, F.G, F.bx); P.W = (const bf16*)(F.ws + WS_WDN); P.wstride = (size_t)D * DFFE / 2; P.gatherA = 0;
                gm::EpiDown E{YP, (const int*)(F.ws + WS_LIST), moe, 1.0f / (HID_SCALE * WDN_SCALE)};
                gm::gemm_phase<false, gm::EpiDown, gm::FfnPolicy, 2>(F.lds, PROJ, ff / 2, P, E);
            }
            if (pass + 1 < npass) SEAM(pb + 7 + 2 * pass);
        }
        if (IN(pb + 6 + 2 * npass - 1) && IN(pb + 12)) xcd_barrier(bar);
        if (IN(pb + 12)) {
            const float* gm_ = modp + (size_t)(layer * 2 + 1) * NB * 3072;
            const float* nm = (layer + 1 < DEPTH) ? modp + (size_t)((layer + 1) * 2 + 0) * NB * 3072 : nullptr;
            if (moe) ln_phase<1, false, 2>(F, args.in[0], true, layer + 1 < DEPTH, YP, gm_, args.in[15] + (size_t)(layer * 2 + 1) * D, args.in[16] + (size_t)(layer * 2 + 1) * D, nm, nullptr, 0);
            else ln_phase<0, false, 2>(F, args.in[0], true, layer + 1 < DEPTH, YP, gm_, args.in[15] + (size_t)(layer * 2 + 1) * D, args.in[16] + (size_t)(layer * 2 + 1) * D, nm, nullptr, 0);
            if (layer + 1 < DEPTH) { __syncthreads(); conv_layer(F, args, layer + 1); conv_win(F, args, layer + 1); }
        }
        if (layer + 1 < DEPTH) SEAM(pb + 12);
    }
#undef IN
#undef SEAM
}

extern "C" void kernel_launch(void* const* d_in, const int* in_sizes, int n_in, void* d_out, int out_size, void* d_ws, size_t ws_size, hipStream_t stream) {
    static int grid = 0;
    if (grid == 0) {
        if (n_in != 17 || in_sizes[0] != M * D || out_size != M * D || ws_size < WS_END) { fprintf(stderr, "kernel_launch: unexpected shapes / workspace (%d inputs, ws %zu, need %zu); nothing launched\n", n_in, ws_size, (size_t)WS_END); grid = -1; return; }
        int dev = 0, cus = 0, per_cu = 0;
        if (hipGetDevice(&dev) != hipSuccess || hipDeviceGetAttribute(&cus, hipDeviceAttributeMultiprocessorCount, dev) != hipSuccess) { grid = -1; return; }
        if (hipFuncSetAttribute((const void*)fwd_kernel, hipFuncAttributeMaxDynamicSharedMemorySize, LDS_BYTES) != hipSuccess) { fprintf(stderr, "kernel_launch: hipFuncSetAttribute failed\n"); grid = -1; return; }
        if (hipOccupancyMaxActiveBlocksPerMultiprocessor(&per_cu, (const void*)fwd_kernel, NTHR, LDS_BYTES) != hipSuccess || per_cu < 1) fprintf(stderr, "kernel_launch: occupancy query reports %d\n", per_cu);
        (void)hipGetLastError();
        grid = cus;
    }
    if (grid < 0) return;
    if (hipMemsetAsync((char*)d_ws + WS_CTL, 0, CTL_ZERO_BYTES, stream) != hipSuccess) return;
    Args a{};
    for (int i = 0; i < 17; ++i) a.in[i] = (const float*)d_in[i];
    a.out = (float*)d_out; a.ws = (unsigned char*)d_ws;
#if MK_PER_PHASE_LAUNCH
    for (int p = 0; p < N_PHASES; ++p) {
        const int slot = (p - 2) % PH_PER_LAYER, layer = (p - 2) / PH_PER_LAYER;
        if (p >= 2 && (layer & 1) == 0 && slot >= 8 && slot <= 11) continue;
        a.ph_lo = p; a.ph_hi = p + 1;
        hipLaunchKernelGGL(fwd_kernel, dim3(grid), dim3(NTHR), LDS_BYTES, stream, a);
    }
#else
    a.ph_lo = 0; a.ph_hi = N_PHASES;
    hipLaunchKernelGGL(fwd_kernel, dim3(grid), dim3(NTHR), LDS_BYTES, stream, a);
#endif
}
```
